# Optimizing an MI355X kernel written in HIP

```python
import math
import jax
import jax.numpy as jnp
from jax import lax
import numpy as np

D_MODEL = 1024
BATCH = 16
SEQ = 2048
DEPTH = 1
DEC_BATCH = 32
DEC_SEQ = 64
PAST_LEN = 4096

CHUNK = 64
LEFT_CHUNKS = 8
BAND = (LEFT_CHUNKS + 1) * CHUNK
ATT_REACH = LEFT_CHUNKS * CHUNK
ATT_WIDTH = D_MODEL // 2
N_HEADS = 8
HEAD_DIM = ATT_WIDTH // N_HEADS
REL_CLIP = 256
ATT_SCALE = HEAD_DIM ** -0.5
SSM_WIDTH = D_MODEL // 2
SSM_GROUP = 16
N_GROUPS = SSM_WIDTH // SSM_GROUP
STATE_DIM = 64
DT_MIN = 1e-3
DT_MAX = 1e-1
D_FF = ((8 * D_MODEL + 3 * 256 - 1) // (3 * 256)) * 256
IN_WIDTH = 3 * ATT_WIDTH + SSM_WIDTH + 2 * D_MODEL
ALPHA = (2 * DEPTH) ** 0.25
BETA = (8 * DEPTH) ** -0.25
LN_EPS = 1e-5
NEG_INF = -1e30

kernel_name = "hybrid_chunk_band_attn_s5_stream_step"


def layer_norm(x, gain=None, bias=None):
    xf = x.astype(jnp.float32)
    xc = xf - jnp.mean(xf, axis=-1, keepdims=True)
    y = xc * lax.rsqrt(jnp.mean(xc * xc, axis=-1, keepdims=True) + LN_EPS)
    if gain is not None:
        y = y * gain.astype(jnp.float32) + bias.astype(jnp.float32)
    return y.astype(x.dtype)


def modulate(x, shift, scale):
    return layer_norm(x) * (1 + scale) + shift


def rel_bias_lookup(rel_bias, dist):
    idx = jnp.clip(dist, -REL_CLIP, REL_CLIP) + REL_CLIP
    return rel_bias[:, idx].astype(jnp.float32)


def band_attention_prompt(q, k, v, rel_bias):
    bsz, seq, nh, hd = q.shape
    n_chunks = seq // CHUNK
    pad = LEFT_CHUNKS * CHUNK
    kp = jnp.pad(k, ((0, 0), (pad, 0), (0, 0), (0, 0)))
    vp = jnp.pad(v, ((0, 0), (pad, 0), (0, 0), (0, 0)))
    band_idx = jnp.arange(BAND)
    bias = rel_bias_lookup(rel_bias, jnp.arange(CHUNK)[:, None] + pad - band_idx[None, :])
    qc = q.reshape(bsz, n_chunks, CHUNK, nh, hd).swapaxes(0, 1)

    def one_chunk(args):
        q_c, c_idx = args
        k_b = lax.dynamic_slice_in_dim(kp, c_idx * CHUNK, BAND, axis=1)
        v_b = lax.dynamic_slice_in_dim(vp, c_idx * CHUNK, BAND, axis=1)
        s = jnp.einsum('bqhd,bkhd->bhqk', q_c, k_b).astype(jnp.float32) * ATT_SCALE + bias
        valid = band_idx >= (LEFT_CHUNKS - c_idx) * CHUNK
        s = jnp.where(valid, s, NEG_INF)
        p = jax.nn.softmax(s, axis=-1).astype(v_b.dtype)
        return jnp.einsum('bhqk,bkhd->bqhd', p, v_b)

    o = lax.map(one_chunk, (qc, jnp.arange(n_chunks)))
    return o.swapaxes(0, 1).reshape(bsz, seq, nh, hd)


def band_attention_sample(q, k, v, cache_k, cache_v, rel_bias):
    n_new = q.shape[1]
    win = cache_k.shape[1]
    kk = jnp.concatenate([cache_k.astype(k.dtype), k], axis=1)
    vv = jnp.concatenate([cache_v.astype(v.dtype), v], axis=1)
    dist = jnp.arange(n_new)[:, None] + win - jnp.arange(win + n_new)[None, :]
    s = jnp.einsum('bqhd,bkhd->bhqk', q, kk).astype(jnp.float32) * ATT_SCALE + rel_bias_lookup(rel_bias, dist)
    p = jax.nn.softmax(s, axis=-1).astype(vv.dtype)
    return jnp.einsum('bhqk,bkhd->bqhd', p, vv)


def s5_discretize(a_re, a_im, log_dt, b_re, b_im):
    a_re = a_re.astype(jnp.float32)
    a_im = a_im.astype(jnp.float32)
    b_re = b_re.astype(jnp.float32)
    b_im = b_im.astype(jnp.float32)
    dt = jnp.exp(log_dt.astype(jnp.float32))[:, None]
    mag = jnp.exp(dt * a_re)
    ang = dt * a_im
    abar_re = mag * jnp.cos(ang)
    abar_im = mag * jnp.sin(ang)
    den = a_re * a_re + a_im * a_im
    n_re = abar_re - 1
    f_re = (n_re * a_re + abar_im * a_im) / den
    f_im = (abar_im * a_re - n_re * a_im) / den
    bbar_re = f_re[..., None] * b_re - f_im[..., None] * b_im
    bbar_im = f_re[..., None] * b_im + f_im[..., None] * b_re
    return abar_re, abar_im, bbar_re, bbar_im


def complex_affine_combine(e1, e2):
    a1r, a1i, b1r, b1i = e1
    a2r, a2i, b2r, b2i = e2
    return (a2r * a1r - a2i * a1i,
            a2r * a1i + a2i * a1r,
            a2r * b1r - a2i * b1i + b2r,
            a2r * b1i + a2i * b1r + b2i)


def s5_layer(u, s0_re, s0_im, a_re, a_im, log_dt, b_re, b_im, c_re, c_im, d_skip):
    bsz, seq, _ = u.shape
    uf = u.astype(jnp.float32)
    ug = uf.reshape(bsz, seq, N_GROUPS, SSM_GROUP)
    abar_re, abar_im, bbar_re, bbar_im = s5_discretize(a_re, a_im, log_dt, b_re, b_im)
    bu_re = jnp.einsum('blgm,gpm->lbgp', ug, bbar_re)
    bu_im = jnp.einsum('blgm,gpm->lbgp', ug, bbar_im)
    s0r = s0_re.astype(jnp.float32)
    s0i = s0_im.astype(jnp.float32)
    bu_re = bu_re.at[0].add(abar_re * s0r - abar_im * s0i)
    bu_im = bu_im.at[0].add(abar_re * s0i + abar_im * s0r)
    a_r = jnp.broadcast_to(abar_re, (seq, 1, N_GROUPS, STATE_DIM))
    a_i = jnp.broadcast_to(abar_im, (seq, 1, N_GROUPS, STATE_DIM))
    _, _, s_re, s_im = lax.associative_scan(complex_affine_combine, (a_r, a_i, bu_re, bu_im), axis=0)
    y = (jnp.einsum('lbgp,gmp->blgm', s_re, c_re.astype(jnp.float32))
         - jnp.einsum('lbgp,gmp->blgm', s_im, c_im.astype(jnp.float32)))
    y = y.reshape(bsz, seq, SSM_WIDTH) + d_skip.astype(jnp.float32) * uf
    return y.astype(u.dtype), s_re[-1].astype(u.dtype), s_im[-1].astype(u.dtype)


def encoder_layer(x, c, cache_k, cache_v, s0_re, s0_im, p):
    (w_ada, b_ada, w_in, rel_bias, a_re, a_im, log_dt, b_re, b_im, c_re, c_im, d_skip,
     w_attn_proj, w_glu, w_out, ln1_g, ln1_b, w_ffn_in, w_ffn_out, ln2_g, ln2_b) = p
    bsz, seq, _ = x.shape
    mod = (jax.nn.silu(c) @ w_ada + b_ada)[:, None, :]
    sh1, sc1, g1, sh2, sc2, g2 = jnp.split(mod, 6, axis=-1)

    h = modulate(x, sh1, sc1)
    z = h @ w_in
    q, k, v, u, ga, gb = jnp.split(
        z, [ATT_WIDTH, 2 * ATT_WIDTH, 3 * ATT_WIDTH, 3 * ATT_WIDTH + SSM_WIDTH,
            3 * ATT_WIDTH + SSM_WIDTH + D_MODEL], axis=-1)
    q = q.reshape(bsz, seq, N_HEADS, HEAD_DIM)
    k = k.reshape(bsz, seq, N_HEADS, HEAD_DIM)
    v = v.reshape(bsz, seq, N_HEADS, HEAD_DIM)
    if cache_k is None:
        o_att = band_attention_prompt(q, k, v, rel_bias)
        keep = min(ATT_REACH, seq)
        k_state, v_state = k[:, seq - keep:], v[:, seq - keep:]
    else:
        o_att = band_attention_sample(q, k, v, cache_k, cache_v, rel_bias)
        k_state, v_state = k, v
    o_att = o_att.reshape(bsz, seq, ATT_WIDTH) @ w_attn_proj

    y_ssm, s_re, s_im = s5_layer(u, s0_re, s0_im, a_re, a_im, log_dt, b_re, b_im, c_re, c_im, d_skip)
    glu_a, glu_b = jnp.split(jax.nn.gelu(y_ssm) @ w_glu, 2, axis=-1)
    o_ssm = glu_a * jax.nn.sigmoid(glu_b)

    mixed = jax.nn.sigmoid(ga) * o_att + jax.nn.sigmoid(gb) * o_ssm
    x = layer_norm(ALPHA * x + g1 * (mixed @ w_out), ln1_g, ln1_b)

    h = modulate(x, sh2, sc2)
    f_gate, f_up = jnp.split(h @ w_ffn_in, 2, axis=-1)
    f = (jax.nn.silu(f_gate) * f_up) @ w_ffn_out
    x = layer_norm(ALPHA * x + g2 * f, ln2_g, ln2_b)
    return x, k_state, v_state, s_re, s_im


def setup_inputs(seed: int = 0) -> dict:
    key = jax.random.key(seed)
    ks = jax.random.split(key, 32)
    f32 = jnp.float32

    def nrm(k, shape, scale):
        return jax.random.normal(k, shape, f32) * scale

    cache_rows = min(ATT_REACH, PAST_LEN)
    a_im_init = math.pi * jnp.arange(STATE_DIM, dtype=f32)
    return {
        'x_prompt': nrm(ks[0], (BATCH, SEQ, D_MODEL), 1.0),
        'x_sample': nrm(ks[1], (DEC_BATCH, DEC_SEQ, D_MODEL), 1.0),
        'c_prompt': nrm(ks[2], (BATCH, D_MODEL), 1.0),
        'c_sample': nrm(ks[3], (DEC_BATCH, D_MODEL), 1.0),
        'cache_attn_k': nrm(ks[4], (DEPTH, DEC_BATCH, cache_rows, N_HEADS, HEAD_DIM), 1.0),
        'cache_attn_v': nrm(ks[5], (DEPTH, DEC_BATCH, cache_rows, N_HEADS, HEAD_DIM), 1.0),
        'state_ssm_re': nrm(ks[6], (DEPTH, DEC_BATCH, N_GROUPS, STATE_DIM), 0.1),
        'state_ssm_im': nrm(ks[7], (DEPTH, DEC_BATCH, N_GROUPS, STATE_DIM), 0.1),
        'w_ada': nrm(ks[8], (DEPTH, D_MODEL, 6 * D_MODEL), D_MODEL ** -0.5),
        'b_ada': nrm(ks[9], (DEPTH, 6 * D_MODEL), 0.01),
        'w_in': nrm(ks[10], (DEPTH, D_MODEL, IN_WIDTH), D_MODEL ** -0.5),
        'rel_bias': nrm(ks[11], (DEPTH, N_HEADS, 2 * REL_CLIP + 1), 0.1),
        'ssm_a_re': -0.5 + nrm(ks[12], (DEPTH, N_GROUPS, STATE_DIM), 0.01),
        'ssm_a_im': a_im_init + nrm(ks[13], (DEPTH, N_GROUPS, STATE_DIM), 0.01),
        'ssm_log_dt': jax.random.uniform(ks[14], (DEPTH, N_GROUPS), f32, math.log(DT_MIN), math.log(DT_MAX)),
        'ssm_b_re': nrm(ks[15], (DEPTH, N_GROUPS, STATE_DIM, SSM_GROUP), (2 * SSM_GROUP) ** -0.5),
        'ssm_b_im': nrm(ks[16], (DEPTH, N_GROUPS, STATE_DIM, SSM_GROUP), (2 * SSM_GROUP) ** -0.5),
        'ssm_c_re': nrm(ks[17], (DEPTH, N_GROUPS, SSM_GROUP, STATE_DIM), (2 * STATE_DIM) ** -0.5),
        'ssm_c_im': nrm(ks[18], (DEPTH, N_GROUPS, SSM_GROUP, STATE_DIM), (2 * STATE_DIM) ** -0.5),
        'ssm_d': nrm(ks[19], (DEPTH, SSM_WIDTH), 1.0),
        'w_attn_proj': nrm(ks[20], (DEPTH, ATT_WIDTH, D_MODEL), ATT_WIDTH ** -0.5),
        'w_glu': nrm(ks[21], (DEPTH, SSM_WIDTH, 2 * D_MODEL), SSM_WIDTH ** -0.5),
        'w_out': nrm(ks[22], (DEPTH, D_MODEL, D_MODEL), BETA * D_MODEL ** -0.5),
        'ln1_g': 1.0 + nrm(ks[23], (DEPTH, D_MODEL), 0.01),
        'ln1_b': nrm(ks[24], (DEPTH, D_MODEL), 0.01),
        'w_ffn_in': nrm(ks[25], (DEPTH, D_MODEL, 2 * D_FF), D_MODEL ** -0.5),
        'w_ffn_out': nrm(ks[26], (DEPTH, D_FF, D_MODEL), BETA * D_FF ** -0.5),
        'ln2_g': 1.0 + nrm(ks[27], (DEPTH, D_MODEL), 0.01),
        'ln2_b': nrm(ks[28], (DEPTH, D_MODEL), 0.01),
    }


def reference(x_prompt, x_sample, c_prompt, c_sample, cache_attn_k, cache_attn_v, state_ssm_re, state_ssm_im,
              w_ada, b_ada, w_in, rel_bias, ssm_a_re, ssm_a_im, ssm_log_dt, ssm_b_re, ssm_b_im, ssm_c_re, ssm_c_im,
              ssm_d, w_attn_proj, w_glu, w_out, ln1_g, ln1_b, w_ffn_in, w_ffn_out, ln2_g, ln2_b):
    y_prompt, y_sample = x_prompt, x_sample
    k_p, v_p, re_p, im_p = [], [], [], []
    k_s, v_s, re_s, im_s = [], [], [], []
    for l in range(DEPTH):
        p = (w_ada[l], b_ada[l], w_in[l], rel_bias[l], ssm_a_re[l], ssm_a_im[l], ssm_log_dt[l],
             ssm_b_re[l], ssm_b_im[l], ssm_c_re[l], ssm_c_im[l], ssm_d[l], w_attn_proj[l], w_glu[l],
             w_out[l], ln1_g[l], ln1_b[l], w_ffn_in[l], w_ffn_out[l], ln2_g[l], ln2_b[l])
        s0 = jnp.zeros((x_prompt.shape[0], N_GROUPS, STATE_DIM), x_prompt.dtype)
        y_prompt, kp, vp, srp, sip = encoder_layer(y_prompt, c_prompt, None, None, s0, s0, p)
        y_sample, kss, vss, srs, sis = encoder_layer(y_sample, c_sample, cache_attn_k[l], cache_attn_v[l],
                                                     state_ssm_re[l], state_ssm_im[l], p)
        k_p.append(kp)
        v_p.append(vp)
        re_p.append(srp)
        im_p.append(sip)
        k_s.append(kss)
        v_s.append(vss)
        re_s.append(srs)
        im_s.append(sis)
    return (y_prompt, y_sample, jnp.stack(k_p), jnp.stack(v_p), jnp.stack(re_p), jnp.stack(im_p),
            jnp.stack(k_s), jnp.stack(v_s), jnp.stack(re_s), jnp.stack(im_s))
```

```cpp
#include <hip/hip_runtime.h>
#include <hip/hip_cooperative_groups.h>
#include <cstdio>
#include <cstdint>
namespace cg = cooperative_groups;

#ifndef HOSTREP
#define HOSTREP 0
#endif
#ifndef MK_LAUNCHES
#define MK_LAUNCHES 1
#endif

#define LAS __attribute__((address_space(3)))
typedef unsigned short bf16_t;
typedef short bf16x8 __attribute__((ext_vector_type(8)));
typedef float f32x4 __attribute__((ext_vector_type(4)));
typedef unsigned u32x4 __attribute__((ext_vector_type(4)));
typedef unsigned u32x2 __attribute__((ext_vector_type(2)));
typedef float f32x2 __attribute__((ext_vector_type(2)));

constexpr int DM = 1024, NB = 16, SEQ = 2048, DB = 32, DS = 64;
constexpr int MP = NB * SEQ, MS = DB * DS, MT = MP + MS;
constexpr int NG = 32, DFF = 2816, KSL = 576;
constexpr int UK = 1152;
constexpr float ALPHA = 1.189207115002721f;
constexpr float LOG2E = 1.4426950408889634f;
constexpr int NPHASE = 12;

constexpr size_t O_Y = 0, O_KP = 35651584, O_VP = 39845888, O_SRP = 44040192, O_SIP = 44072960,
                 O_KS = 44105728, O_VS = 45154304, O_SRS = 46202880, O_SIS = 46268416;

constexpr size_t W_MOD = 0;
constexpr size_t W_WIN = W_MOD + 1179648;
constexpr size_t W_WAP = W_WIN + 8388608;
constexpr size_t W_WGLU = W_WAP + 1048576;
constexpr size_t W_WOUT = W_WGLU + 2097152;
constexpr size_t W_WFI = W_WOUT + 2097152;
constexpr size_t W_WFO = W_WFI + 11534336;
constexpr size_t W_KTAB = W_WFO + 5767168;
constexpr size_t W_ABT = W_KTAB + 2097152;
constexpr size_t W_WE = W_ABT + 16384;
constexpr size_t W_R1 = W_WE + 8388608;
constexpr size_t W_WY = W_R1;
constexpr size_t W_UG = W_WY + 75497472;
constexpr size_t W_EBUF = W_UG + 56623104;
constexpr size_t W_R2 = W_EBUF + 12582912;
constexpr size_t W_H = W_R2;
constexpr size_t W_R3 = W_H + 71303168;
constexpr size_t W_Q = W_R3;
constexpr size_t W_KP = W_Q + 35651584;
constexpr size_t W_KS = W_KP + 33554432;
constexpr size_t W_VT = W_KS + 18874368;
constexpr size_t W_VTS = W_VT + 33554432;
constexpr size_t W_GY = W_VTS + 18874368;
constexpr size_t W_BAR = W_R3 + 196083712;
constexpr size_t W_END = W_BAR + 16384;
constexpr size_t W_X1 = W_R1;
constexpr size_t W_MIX = W_WY;
constexpr size_t W_OATT = W_H;
constexpr size_t W_P1 = W_Q;
constexpr size_t W_ACT = W_R3;
static_assert(W_GY + 35651584 <= W_END, "R3");
static_assert(W_X1 + 142606336 <= W_R2, "X1");

constexpr int LDS_BYTES = 131072 + 1024;

struct Params { const float* in[29]; float* out; unsigned char* ws; int ph_lo, ph_hi; };

__device__ __forceinline__ unsigned cvt_pk_bf16(float lo, float hi) { unsigned r; asm volatile("v_cvt_pk_bf16_f32 %0, %1, %2" : "=v"(r) : "v"(lo), "v"(hi)); return r; }
__device__ __forceinline__ float bf_lo(unsigned u) { return __builtin_bit_cast(float, u << 16); }
__device__ __forceinline__ float bf_hi(unsigned u) { return __builtin_bit_cast(float, u & 0xffff0000u); }
__device__ __forceinline__ float sigmoidf_(float x) { return __builtin_amdgcn_rcpf(1.0f + __builtin_amdgcn_exp2f(-x * LOG2E)); }
__device__ __forceinline__ float sig2_(float x, float y) { return __builtin_amdgcn_rcpf((1.0f + __builtin_amdgcn_exp2f(-x * LOG2E)) * (1.0f + __builtin_amdgcn_exp2f(-y * LOG2E))); }
__device__ __forceinline__ float gelu_tanh(float x) { const float z = 1.5957691216057308f * (x + 0.044715f * x * x * x); return x * sigmoidf_(z); }
__device__ __forceinline__ float wave_sum(float v) {
#pragma unroll
    for (int o = 32; o >= 1; o >>= 1) v += __shfl_xor(v, o);
    return v;
}
__device__ __forceinline__ u32x4 pack8(const f32x4 a, const f32x4 b) { u32x4 r; r[0] = cvt_pk_bf16(a[0], a[1]); r[1] = cvt_pk_bf16(a[2], a[3]); r[2] = cvt_pk_bf16(b[0], b[1]); r[3] = cvt_pk_bf16(b[2], b[3]); return r; }
__device__ __forceinline__ void unpack8(const u32x4 u, f32x4& a, f32x4& b) { a[0] = bf_lo(u[0]); a[1] = bf_hi(u[0]); a[2] = bf_lo(u[1]); a[3] = bf_hi(u[1]); b[0] = bf_lo(u[2]); b[1] = bf_hi(u[2]); b[2] = bf_lo(u[3]); b[3] = bf_hi(u[3]); }
#ifndef NT_STORES
#define NT_STORES 0
#endif
__device__ __forceinline__ void st16(void* p, const u32x4 v) { if (NT_STORES) __builtin_nontemporal_store(v, (u32x4*)p); else *(u32x4*)p = v; }
__device__ __forceinline__ unsigned sigq4(const f32x4 v) {
    unsigned r = 0;
#pragma unroll
    for (int e = 0; e < 4; ++e) { const float sg = sigmoidf_(v[e]); const unsigned q = (unsigned)(sg * 255.0f + 0.5f); r |= (q > 255u ? 255u : q) << (8 * e); }
    return r;
}
__device__ __forceinline__ f32x4 deq4(unsigned u) { f32x4 r; r[0] = (float)(u & 0xffu); r[1] = (float)((u >> 8) & 0xffu); r[2] = (float)((u >> 16) & 0xffu); r[3] = (float)(u >> 24); return r * (1.0f / 255.0f); }
__device__ __forceinline__ f32x4 ldnt4(const float* p) { return __builtin_nontemporal_load((const f32x4*)p); }
__device__ __forceinline__ u32x2 ldnt2(const void* p) { return __builtin_nontemporal_load((const u32x2*)p); }
__device__ __forceinline__ void stnt4(float* p, const f32x4 v) { __builtin_nontemporal_store(v, (f32x4*)p); }
__device__ __forceinline__ int modrow_of(int r) { return r < MP ? (r >> 11) : 16 + ((r - MP) >> 6); }

#ifndef PG8_SP2
#define PG8_SP2 true
#endif
#ifndef PG8_ALIGN
#define PG8_ALIGN true
#endif
namespace pg8 {
constexpr int BM = 256, BK = 64, HALF = 128, HTB = HALF * BK * 2, NXCD = 8, WGM = 8;
__device__ __forceinline__ int lds_byte(int r, int c) { const int st = (r >> 4) * 2 + (c >> 5), rr = r & 15, cc = c & 31, ob = rr * 64 + cc * 2; return st * 1024 + (ob ^ (((ob >> 9) & 1) << 5)); }
__device__ __forceinline__ void stage_rc(int b, int& R, int& C) { const int st = b / 1024, sb = b % 1024, swz = sb ^ (((sb >> 9) & 1) << 5); R = (st >> 1) * 16 + swz / 64; C = (st & 1) * 32 + (swz % 64) / 2; }
__device__ __forceinline__ int perm32(int rho) { const int n = rho >> 4, i = rho & 15; return 8 * (i >> 2) + 4 * n + (i & 3); }

struct Unit { int ra, rb, a, b, kt, k0, part, half; };

struct TileSched {
    int nM, nN, nwg, G, c, kt;
    __device__ void init(int M, int N, int K, int G_, int c_) { nM = M / BM; nN = N / BM; nwg = nM * nN; G = G_; c = c_; kt = K / BK; }
    __device__ bool next(int i, Unit& u) const {
        const long L = (long)i * G + c; if (L >= nwg) return false;
        int wgid = (int)L; { const int q = nwg / NXCD, r = nwg % NXCD, xcd = wgid % NXCD, off = wgid / NXCD; wgid = (xcd < r ? xcd * (q + 1) : r * (q + 1) + (xcd - r) * q) + off; }
        const int nig = WGM * nN, gid = wgid / nig, fm = gid * WGM, gsz = (nM - fm) < WGM ? (nM - fm) : WGM;
        u.a = fm + ((wgid % nig) % gsz); u.b = (wgid % nig) / gsz; u.ra = u.a * BM; u.rb = u.b * BM; u.kt = kt; u.k0 = 0; u.part = 0; u.half = 0; return true;
    }
};
struct ESched {
    int G, c;
    __device__ bool next(int i, Unit& u) const { const int L = i * G + c; if (L >= 96) return false; const int g = L / 3, mt = L % 3; u.ra = g * 768 + mt * 256; u.rb = g * 128; u.a = g; u.b = mt; u.kt = 16; u.k0 = 0; u.part = 0; u.half = (mt == 2); return true; }
};
struct YSched {
    int G, c;
    __device__ bool next(int i, Unit& u) const { const int L = i * G + c; if (L >= 384) return false; const int ntc = 3 - L / 96, idx = L % 96, g = idx / 3, mt = idx % 3;
        u.ra = g * 768 + mt * 256; u.rb = g * 1024 + ntc * 256; u.a = g; u.b = mt * 4 + ntc; u.kt = 6 + 4 * ntc; u.k0 = 0; u.part = 0; u.half = (mt == 2); return true; }
};
struct APSched {
    int G, c;
    __device__ bool next(int i, Unit& u) const { int id;
        if (G == 256) { int lo, n; if (c < 96) { lo = c; n = 1; } else if (c < 128) { lo = 96 + 2 * (c - 96); n = 2; } else if (c < 192) { lo = 160 + 3 * (c - 128); n = 3; } else { lo = 352 + 3 * (c - 192); n = 3; }
            if (i >= n) return false; id = lo + i; }
        else { id = i * G + c; if (id >= 544) return false; }
        u.a = id >> 2; u.b = id & 3; u.ra = u.a * BM; u.rb = u.b * BM; u.kt = 8; u.k0 = 0; u.part = 0; u.half = 0; return true; }
};

struct ResSched {
    int G, c, ktot, S;
    __device__ bool next(int i, Unit& u) const {
        u.half = 0;
        if (G == 256) {
            if (i < 2) { const int id = i * 256 + c; u.a = id >> 2; u.b = id & 3; u.kt = ktot; u.k0 = 0; u.part = 0; u.half = 0; }
            else if (i == 2) { if (c >= 32 * S) return false; const int un = c / S, sl = c % S; u.a = 128 + (un >> 2); u.b = un & 3;
                if (S == 8) { u.k0 = sl < 6 ? 6 * sl : 36 + 4 * (sl - 6); u.kt = sl < 6 ? 6 : 4; } else { u.k0 = 4 * sl; u.kt = 4; }
                u.part = 1 + sl; }
            else return false;
        } else { const int id = i * G + c; if (id >= 544) return false; u.a = id >> 2; u.b = id & 3; u.kt = ktot; u.k0 = 0; u.part = 0; u.half = 0; }
        u.ra = u.a * BM; u.rb = u.b * BM; return true;
    }
};

template <bool ABLK = false, class Epi, class Sched>
__device__ __forceinline__ void gemm_phase(LAS unsigned char* lds, const bf16_t* A, int lda, const bf16_t* Bt, int ldb, const Sched& S, const Epi& E, int ktot = 0) {
    const int tid = threadIdx.x, wid = __builtin_amdgcn_readfirstlane(tid >> 6), lane = tid & 63, wr = wid >> 2, wc = wid & 3, fr = lane & 15, fq = lane >> 4;
    unsigned voffA[2], voffB[2];
#pragma unroll
    for (int i = 0; i < 2; ++i) { int R, C; stage_rc(tid * 16 + i * 8192, R, C); const int Rb = (R & ~31) + perm32(R & 31);
        voffA[i] = (unsigned)(R * (ABLK ? 64 : lda) + C) * 2u; voffB[i] = (unsigned)(Rb * ldb + C) * 2u; }
    const size_t kstepB = (size_t)(BK * 2), kstepA = ABLK ? (size_t)32768 : kstepB;
    const size_t hstepA = ABLK ? (size_t)16384 : (size_t)HALF * lda * 2, hstepB = (size_t)HALF * ldb * 2;
    const size_t ustepA = ABLK ? (size_t)ktot * 32768 / 256 : (size_t)lda * 2;
    const unsigned ldsw = (unsigned)wid * 1024u;
    const int aoff = lds_byte(wr * 64 + fr, fq * 8), boff = lds_byte(wc * 32 + fr, fq * 8);
#define PG8_SA(b, h) (((b) * 2 + (h)) * HTB)
#define PG8_SB(b, h) ((4 + (b) * 2 + (h)) * HTB)
#define PG8_STAGE(bufoff, gbase, voff) do { _Pragma("unroll") for (int _i = 0; _i < 2; ++_i) \
        __builtin_amdgcn_global_load_lds((const unsigned*)((const char*)(gbase) + (voff)[_i]), (LAS unsigned*)(lds + (bufoff) + ldsw + _i * 8192), 16, 0, 0); } while (0)
#define PG8_LDA(dst, b, h) do { _Pragma("unroll") for (int m = 0; m < 4; ++m) _Pragma("unroll") for (int k = 0; k < 2; ++k) dst[m][k] = *(const LAS bf16x8*)(lds + PG8_SA(b, h) + aoff + m * 2048 + k * 1024); } while (0)
#define PG8_LDB(dst, b, h) do { _Pragma("unroll") for (int n = 0; n < 2; ++n) _Pragma("unroll") for (int k = 0; k < 2; ++k) dst[n][k] = *(const LAS bf16x8*)(lds + PG8_SB(b, h) + boff + n * 2048 + k * 1024); } while (0)
#define PG8_MMA(ai, bj, At, Bt_) do { __builtin_amdgcn_s_setprio(1); _Pragma("unroll") for (int m = 0; m < 4; ++m) _Pragma("unroll") for (int n = 0; n < 2; ++n) _Pragma("unroll") for (int k = 0; k < 2; ++k) \
        acc[ai][bj][m][n] = __builtin_amdgcn_mfma_f32_16x16x32_bf16(Bt_[n][k], At[m][k], acc[ai][bj][m][n], 0, 0, 0); __builtin_amdgcn_s_setprio(0); } while (0)
#define PG8_WAIT_V(n) asm volatile("s_waitcnt vmcnt(" #n ")" ::: "memory")
#define PG8_WAIT_L(n) asm volatile("s_waitcnt lgkmcnt(" #n ")" ::: "memory")
#define PG8_BAR __builtin_amdgcn_s_barrier()
#define PG8_SCHED __builtin_amdgcn_sched_barrier(0)
    Unit cur, nxt; int ui = 0;
    if (!S.next(0, cur)) return;
    f32x4 acc[2][2][4][2];
#pragma unroll
    for (int a = 0; a < 2; ++a)
#pragma unroll
        for (int b = 0; b < 2; ++b)
#pragma unroll
            for (int m = 0; m < 4; ++m)
#pragma unroll
                for (int n = 0; n < 2; ++n) acc[a][b][m][n] = (f32x4){0.f, 0.f, 0.f, 0.f};
    bf16x8 At[4][2], B0[2][2], B1[2][2];
    const char* cA = (const char*)A + (size_t)cur.ra * ustepA + (size_t)cur.k0 * kstepA; const char* cB = (const char*)Bt + (size_t)cur.rb * ldb * 2 + (size_t)cur.k0 * kstepB;
    if constexpr (PG8_SP2) {
        PG8_STAGE(PG8_SB(0, 0), cB, voffB); PG8_STAGE(PG8_SB(0, 1), cB + hstepB, voffB); PG8_STAGE(PG8_SA(0, 0), cA, voffA); PG8_STAGE(PG8_SA(0, 1), cA + hstepA, voffA);
        if (wr == 1) PG8_BAR;
        PG8_WAIT_V(2); PG8_BAR;
        PG8_STAGE(PG8_SB(1, 0), cB + kstepB, voffB); PG8_STAGE(PG8_SA(1, 0), cA + kstepA, voffA); PG8_STAGE(PG8_SB(1, 1), cB + hstepB + kstepB, voffB);
        PG8_WAIT_V(6); PG8_BAR;
    } else {
        PG8_STAGE(PG8_SB(0, 0), cB, voffB); PG8_STAGE(PG8_SA(0, 0), cA, voffA); PG8_STAGE(PG8_SB(0, 1), cB + hstepB, voffB); PG8_STAGE(PG8_SA(0, 1), cA + hstepA, voffA);
        if (wr == 1) PG8_BAR;
        PG8_WAIT_V(4); PG8_BAR;
        PG8_STAGE(PG8_SB(1, 0), cB + kstepB, voffB); PG8_STAGE(PG8_SA(1, 0), cA + kstepA, voffA); PG8_STAGE(PG8_SB(1, 1), cB + hstepB + kstepB, voffB);
        PG8_WAIT_V(6); PG8_BAR;
    }
    for (;;) {
        const bool has_next = S.next(ui + 1, nxt);
        const char* nA = has_next ? (const char*)A + (size_t)nxt.ra * ustepA + (size_t)nxt.k0 * kstepA : cA; const char* nB = has_next ? (const char*)Bt + (size_t)nxt.rb * ldb * 2 + (size_t)nxt.k0 * kstepB : cB;
        const int nt = cur.kt; const bool hf = cur.half != 0;
        for (int t = 0; t < nt; t += 2) {
            const bool last = (t == nt - 2);
            const char* a1 = cA + (size_t)(t + 1) * kstepA;
            const char* a2 = last ? nA : cA + (size_t)(t + 2) * kstepA; const char* b2 = last ? nB : cB + (size_t)(t + 2) * kstepB;
            const char* a3 = a2 + kstepA; const char* b3 = b2 + kstepB;
            if constexpr (PG8_SP2) {
            PG8_LDB(B0, 0, 0); PG8_LDB(B1, 0, 1); PG8_SCHED; PG8_LDA(At, 0, 0); PG8_STAGE(PG8_SA(1, 1), a1 + hstepA, voffA);
            PG8_WAIT_V(8); PG8_WAIT_L(0); PG8_BAR; PG8_MMA(0, 0, At, B0); PG8_MMA(0, 1, At, B1); PG8_BAR; PG8_SCHED;
            PG8_LDA(At, 0, 1); PG8_STAGE(PG8_SB(0, 0), b2, voffB); PG8_STAGE(PG8_SB(0, 1), b2 + hstepB, voffB); PG8_STAGE(PG8_SA(0, 0), a2, voffA);
            PG8_WAIT_V(8); PG8_WAIT_L(0); PG8_BAR; if (!hf) { PG8_MMA(1, 0, At, B0); PG8_MMA(1, 1, At, B1); } PG8_BAR; PG8_SCHED;
            PG8_LDB(B0, 1, 0); PG8_LDB(B1, 1, 1); PG8_SCHED; PG8_LDA(At, 1, 0); PG8_STAGE(PG8_SA(0, 1), a2 + hstepA, voffA);
            PG8_WAIT_V(8); PG8_WAIT_L(0); PG8_BAR; PG8_MMA(0, 0, At, B0); PG8_MMA(0, 1, At, B1); PG8_BAR; PG8_SCHED;
            PG8_LDA(At, 1, 1); PG8_STAGE(PG8_SB(1, 0), b3, voffB); PG8_STAGE(PG8_SB(1, 1), b3 + hstepB, voffB); PG8_STAGE(PG8_SA(1, 0), a3, voffA);
            PG8_WAIT_V(8); PG8_WAIT_L(0); PG8_BAR; if (!hf) { PG8_MMA(1, 0, At, B0); PG8_MMA(1, 1, At, B1); } PG8_BAR; PG8_SCHED;
            } else {
            PG8_LDB(B0, 0, 0); PG8_SCHED; PG8_LDA(At, 0, 0); PG8_STAGE(PG8_SA(1, 1), a1 + hstepA, voffA);
            PG8_WAIT_L(8); PG8_BAR; PG8_WAIT_L(0); PG8_MMA(0, 0, At, B0); PG8_BAR; PG8_SCHED;
            PG8_LDB(B1, 0, 1); PG8_STAGE(PG8_SB(0, 0), b2, voffB);
            PG8_BAR; PG8_WAIT_L(0); PG8_MMA(0, 1, At, B1); PG8_BAR;
            PG8_LDA(At, 0, 1); PG8_STAGE(PG8_SA(0, 0), a2, voffA);
            PG8_BAR; PG8_WAIT_L(0); PG8_MMA(1, 0, At, B0); PG8_BAR; PG8_SCHED;
            PG8_STAGE(PG8_SB(0, 1), b2 + hstepB, voffB);
            PG8_WAIT_V(6); PG8_BAR; PG8_MMA(1, 1, At, B1); PG8_BAR;
            PG8_LDB(B0, 1, 0); PG8_SCHED; PG8_LDA(At, 1, 0); PG8_STAGE(PG8_SA(0, 1), a2 + hstepA, voffA);
            PG8_WAIT_L(8); PG8_BAR; PG8_WAIT_L(0); PG8_MMA(0, 0, At, B0); PG8_BAR; PG8_SCHED;
            PG8_LDB(B1, 1, 1); PG8_STAGE(PG8_SB(1, 0), b3, voffB);
            PG8_BAR; PG8_WAIT_L(0); PG8_MMA(0, 1, At, B1); PG8_BAR;
            PG8_LDA(At, 1, 1); PG8_STAGE(PG8_SA(1, 0), a3, voffA);
            PG8_BAR; PG8_WAIT_L(0); PG8_MMA(1, 0, At, B0); PG8_BAR; PG8_SCHED;
            PG8_STAGE(PG8_SB(1, 1), b3 + hstepB, voffB);
            PG8_WAIT_V(6); PG8_BAR; PG8_MMA(1, 1, At, B1); PG8_BAR;
            }
        }
        if constexpr (PG8_ALIGN) { if (wr == 0) PG8_BAR; }
        { int fr2 = fr, fq2 = fq; asm volatile("" : "+v"(fr2), "+v"(fq2)); E(acc, cur, wr, wc, fr2, fq2); }
        if (!has_next) break;
#pragma unroll
        for (int a = 0; a < 2; ++a)
#pragma unroll
            for (int b = 0; b < 2; ++b)
#pragma unroll
                for (int m = 0; m < 4; ++m)
#pragma unroll
                    for (int n = 0; n < 2; ++n) acc[a][b][m][n] = (f32x4){0.f, 0.f, 0.f, 0.f};
        cur = nxt; cA = nA; cB = nB; ++ui;
        if constexpr (PG8_ALIGN) { if (wr == 1) PG8_BAR; }
    }
    PG8_WAIT_V(0);
    if constexpr (!PG8_ALIGN) { if (wr == 0) PG8_BAR; }
    PG8_BAR;
#undef PG8_SA
#undef PG8_SB
#undef PG8_STAGE
#undef PG8_LDA
#undef PG8_LDB
#undef PG8_MMA
#undef PG8_WAIT_V
#undef PG8_WAIT_L
#undef PG8_BAR
#undef PG8_SCHED
}
}
using pg8::Unit;
typedef f32x4 Acc[2][2][4][2];

#define EPI_ROWS_BEGIN _Pragma("unroll") for (int ai = 0; ai < 2; ++ai) _Pragma("unroll") for (int m = 0; m < 4; ++m) { const int rl = 128 * ai + 64 * wr + 16 * m + fr;
#define EPI_ROWS_END }

struct EpiIn {
    bf16_t *Q, *KP, *KS, *VT, *VTS, *UG; unsigned char *GA, *GB; float* out;
    __device__ __forceinline__ void operator()(const Acc& acc, const Unit& u, int wr, int wc, int fr, int fq) const {
        const int pm = u.a, pn = u.b; const bool prm = pm < 128;
        const int c8 = 32 * wc + 8 * fq;
        if (pn < 2) {
            EPI_ROWS_BEGIN { const size_t r = (size_t)pm * 256 + rl;
#pragma unroll
                for (int bj = 0; bj < 2; ++bj) st16(Q + r * 512 + pn * 256 + 128 * bj + c8, pack8(acc[ai][bj][m][0], acc[ai][bj][m][1])); } EPI_ROWS_END
        } else if (pn < 4) {
            EPI_ROWS_BEGIN { const int r = pm * 256 + rl;
#pragma unroll
                for (int bj = 0; bj < 2; ++bj) { const int col = (pn - 2) * 256 + 128 * bj + c8; const u32x4 pk = pack8(acc[ai][bj][m][0], acc[ai][bj][m][1]);
                    if (prm) { const int b = r >> 11, t = r & 2047; st16(KP + (size_t)r * 512 + col, pk);
                        if (t >= 1536) { float* o = out + O_KP + ((size_t)(b * 512 + t - 1536)) * 512 + col; stnt4(o, acc[ai][bj][m][0]); stnt4(o + 4, acc[ai][bj][m][1]); } }
                    else { const int rs = r - MP, b = rs >> 6, t = rs & 63; st16(KS + ((size_t)(b * KSL + 512 + t)) * 512 + col, pk);
                        float* o = out + O_KS + (size_t)rs * 512 + col; stnt4(o, acc[ai][bj][m][0]); stnt4(o + 4, acc[ai][bj][m][1]); } } } EPI_ROWS_END
        } else if (pn < 6) {
            EPI_ROWS_BEGIN { const int r = pm * 256 + rl;
#pragma unroll
                for (int bj = 0; bj < 2; ++bj) { const int col = (pn - 4) * 256 + 128 * bj + c8; const u32x4 pk = pack8(acc[ai][bj][m][0], acc[ai][bj][m][1]);
                    if (prm) { const int b = r >> 11, t = r & 2047; st16(VT + (size_t)r * 512 + col, pk);
                        if (t >= 1536) { float* o = out + O_VP + ((size_t)(b * 512 + t - 1536)) * 512 + col; stnt4(o, acc[ai][bj][m][0]); stnt4(o + 4, acc[ai][bj][m][1]); } }
                    else { const int rs = r - MP, b = rs >> 6, t = rs & 63; st16(VTS + ((size_t)(b * KSL + 512 + t)) * 512 + col, pk);
                        float* o = out + O_VS + (size_t)rs * 512 + col; stnt4(o, acc[ai][bj][m][0]); stnt4(o + 4, acc[ai][bj][m][1]); } } } EPI_ROWS_END
        } else if (pn < 8) {
            EPI_ROWS_BEGIN { const int r = pm * 256 + rl; int row, j;
                if (prm) { const int b = r >> 11, t = r & 2047; row = b * 32 + (t >> 6); j = t & 63; } else { const int rs = r - MP; row = 512 + (rs >> 6); j = rs & 63; }
#pragma unroll
                for (int bj = 0; bj < 2; ++bj) { const int uc = (pn - 6) * 256 + 128 * bj + c8; const int g = uc >> 4, m0 = uc & 15;
                    st16(UG + ((size_t)(g * 768 + row)) * UK + 128 + j * 16 + m0, pack8(acc[ai][bj][m][0], acc[ai][bj][m][1])); } } EPI_ROWS_END
        } else {
            unsigned char* dst = pn < 12 ? GA : GB; const int cb = (pn < 12 ? pn - 8 : pn - 12) * 256;
            EPI_ROWS_BEGIN { const size_t r = (size_t)pm * 256 + rl;
#pragma unroll
                for (int bj = 0; bj < 2; ++bj) { u32x2 q; q[0] = sigq4(acc[ai][bj][m][0]); q[1] = sigq4(acc[ai][bj][m][1]); *(u32x2*)(dst + r * 1024 + cb + 128 * bj + c8) = q; } } EPI_ROWS_END
        }
    }
};

struct EpiE {
    float* EB;
    __device__ __forceinline__ void operator()(const Acc& acc, const Unit& u, int wr, int wc, int fr, int fq) const {
        const int c8 = 32 * wc + 8 * fq;
        EPI_ROWS_BEGIN { float* o = EB + ((size_t)(u.ra + rl)) * 128 + c8; *(f32x4*)o = acc[ai][0][m][0]; *(f32x4*)(o + 4) = acc[ai][0][m][1]; } EPI_ROWS_END
    }
};

struct EpiY {
    bf16_t* GY;
    __device__ __forceinline__ void operator()(const Acc& acc, const Unit& u, int wr, int wc, int fr, int fq) const {
        const int g = u.a, mt = u.b >> 2, ntc = u.b & 3; const int c8 = 32 * wc + 8 * fq;
        EPI_ROWS_BEGIN { int tok0; bool ok = true;
            if (mt < 2) { const int rg = mt * 256 + rl; tok0 = (rg >> 5) * 2048 + (rg & 31) * 64; } else { ok = rl < 32; tok0 = MP + rl * 64; }
            if (ok) {
#pragma unroll
                for (int bj = 0; bj < 2; ++bj) { const int col = ntc * 256 + 128 * bj + c8; const int i = col >> 4, m0 = col & 15;
                    f32x4 a = acc[ai][bj][m][0], b = acc[ai][bj][m][1];
#pragma unroll
                    for (int e = 0; e < 4; ++e) { a[e] = gelu_tanh(a[e]); b[e] = gelu_tanh(b[e]); }
                    st16(GY + ((size_t)(tok0 + i)) * 512 + g * 16 + m0, pack8(a, b)); } } } EPI_ROWS_END
    }
};

struct EpiAP {
    const unsigned char* GA; bf16_t* P1;
    __device__ __forceinline__ void operator()(const Acc& acc, const Unit& u, int wr, int wc, int fr, int fq) const {
        const int c8 = 32 * wc + 8 * fq;
        u32x2 gv[2][4][2];
#pragma unroll
        for (int ai = 0; ai < 2; ++ai) { const size_t base = ((size_t)u.a * 256 + 128 * ai + 64 * wr + fr) * 1024 + u.b * 256 + c8;
#pragma unroll
            for (int m = 0; m < 4; ++m)
#pragma unroll
                for (int bj = 0; bj < 2; ++bj) gv[ai][m][bj] = *(const u32x2*)(GA + base + (size_t)m * 16384 + 128 * bj); }
#pragma unroll
        for (int ai = 0; ai < 2; ++ai)
#pragma unroll
            for (int m = 0; m < 4; ++m)
#pragma unroll
                for (int bj = 0; bj < 2; ++bj) { const f32x4 a = acc[ai][bj][m][0] * deq4(gv[ai][m][bj][0]), b = acc[ai][bj][m][1] * deq4(gv[ai][m][bj][1]);
                    const int col = u.b * 256 + c8 + 128 * bj; st16(P1 + (((size_t)u.a * 16 + (col >> 6)) * 256 + 128 * ai + 64 * wr + fr + 16 * m) * 64 + (col & 63), pack8(a, b)); }
    }
};

struct EpiGLU {
    const unsigned char* GB; const bf16_t* P1; bf16_t* MIX;
    __device__ __forceinline__ void operator()(const Acc& acc, const Unit& u, int wr, int wc, int fr, int fq) const {
        const int c8 = 32 * wc + 8 * fq; const int colg = u.b * 128 + c8;
        u32x2 gv[2][4]; u32x4 pv[2][4];
#pragma unroll
        for (int ai = 0; ai < 2; ++ai) { const size_t base = ((size_t)u.a * 256 + 128 * ai + 64 * wr + fr) * 1024 + colg;
            const size_t bbase = (((size_t)u.a * 16 + (colg >> 6)) * 256 + 128 * ai + 64 * wr + fr) * 64 + (colg & 63);
#pragma unroll
            for (int m = 0; m < 4; ++m) { gv[ai][m] = *(const u32x2*)(GB + base + (size_t)m * 16384); pv[ai][m] = *(const u32x4*)(P1 + bbase + (size_t)m * 1024); } }
#pragma unroll
        for (int ai = 0; ai < 2; ++ai) { const size_t bbase = (((size_t)u.a * 16 + (colg >> 6)) * 256 + 128 * ai + 64 * wr + fr) * 64 + (colg & 63);
#pragma unroll
            for (int m = 0; m < 4; ++m) { f32x4 p0, p1; unpack8(pv[ai][m], p0, p1); const f32x4 g0 = deq4(gv[ai][m][0]), g1 = deq4(gv[ai][m][1]);
                f32x4 a0 = acc[ai][0][m][0], a1 = acc[ai][0][m][1]; const f32x4 b0 = acc[ai][1][m][0], b1 = acc[ai][1][m][1];
#pragma unroll
                for (int e = 0; e < 4; ++e) { a0[e] = p0[e] + a0[e] * g0[e] * sigmoidf_(b0[e]); a1[e] = p1[e] + a1[e] * g1[e] * sigmoidf_(b1[e]); }
                st16(MIX + bbase + (size_t)m * 1024, pack8(a0, a1)); } }
    }
};

__device__ __forceinline__ void atomic_add4(float* p, const f32x4 v) {
#pragma unroll
    for (int e = 0; e < 4; ++e) (void)__hip_atomic_fetch_add(p + e, v[e], __ATOMIC_RELAXED, __HIP_MEMORY_SCOPE_AGENT);
}
template <bool RES_BF16> struct EpiRes {
    const float *xp, *xs; const bf16_t* xb; const float* mod; bf16_t* Tb; float* Ts; int gate_off;
    __device__ __forceinline__ void put(int r, int col, const f32x4 o0, const f32x4 o1, int part) const {
        if (r < MP) st16(Tb + (size_t)r * 1024 + col, pack8(o0, o1));
        else { float* o = Ts + (size_t)(part ? part - 1 : 0) * (2048 * 1024) + (size_t)(r - MP) * 1024 + col; *(f32x4*)o = o0; *(f32x4*)(o + 4) = o1; }
    }
    __device__ __forceinline__ void operator()(const Acc& acc, const Unit& u, int wr, int wc, int fr, int fq) const {
        const int c8 = 32 * wc + 8 * fq; const int part = u.part; const float al = (part >= 2) ? 0.f : ALPHA;
#pragma unroll
        for (int ai = 0; ai < 2; ++ai) {
            const int r0 = u.a * 256 + 128 * ai + 64 * wr + fr;
            const float* gp = mod + (size_t)modrow_of(r0) * 6144 + gate_off;
            const int col0 = u.b * 256 + c8;
            f32x4 gv[2][2];
#pragma unroll
            for (int bj = 0; bj < 2; ++bj)
#pragma unroll
                for (int n = 0; n < 2; ++n) gv[bj][n] = *(const f32x4*)(gp + col0 + 128 * bj + 4 * n);
            if constexpr (RES_BF16) {
                u32x4 xv[4][2];
#pragma unroll
                for (int m = 0; m < 4; ++m)
#pragma unroll
                    for (int bj = 0; bj < 2; ++bj) xv[m][bj] = *(const u32x4*)(xb + (size_t)(r0 + 16 * m) * 1024 + col0 + 128 * bj);
#pragma unroll
                for (int m = 0; m < 4; ++m)
#pragma unroll
                    for (int bj = 0; bj < 2; ++bj) { f32x4 x0, x1; unpack8(xv[m][bj], x0, x1);
                        put(r0 + 16 * m, col0 + 128 * bj, al * x0 + gv[bj][0] * acc[ai][bj][m][0], al * x1 + gv[bj][1] * acc[ai][bj][m][1], part); }
            } else {
                const float* xr = (r0 < MP) ? xp + (size_t)r0 * 1024 : xs + (size_t)(r0 - MP) * 1024;
#pragma unroll
                for (int mp = 0; mp < 2; ++mp) {
                    f32x4 xv[2][2][2];
#pragma unroll
                    for (int mm = 0; mm < 2; ++mm)
#pragma unroll
                        for (int bj = 0; bj < 2; ++bj)
#pragma unroll
                            for (int n = 0; n < 2; ++n) xv[mm][bj][n] = ldnt4(xr + (size_t)(2 * mp + mm) * 16384 + col0 + 128 * bj + 4 * n);
#pragma unroll
                    for (int mm = 0; mm < 2; ++mm)
#pragma unroll
                        for (int bj = 0; bj < 2; ++bj) { const int m = 2 * mp + mm;
                            put(r0 + 16 * m, col0 + 128 * bj, al * xv[mm][bj][0] + gv[bj][0] * acc[ai][bj][m][0], al * xv[mm][bj][1] + gv[bj][1] * acc[ai][bj][m][1], part); }
                }
            }
        }
    }
};

struct EpiFI {
    bf16_t* ACT;
    __device__ __forceinline__ void operator()(const Acc& acc, const Unit& u, int wr, int wc, int fr, int fq) const {
        const int c8 = 32 * wc + 8 * fq;
        EPI_ROWS_BEGIN { const int col = u.b * 128 + c8; const size_t off = (((size_t)u.a * 44 + (col >> 6)) * 256 + rl) * 64 + (col & 63);
            f32x4 a0 = acc[ai][0][m][0], a1 = acc[ai][0][m][1]; const f32x4 b0 = acc[ai][1][m][0], b1 = acc[ai][1][m][1];
#pragma unroll
            for (int e = 0; e < 4; ++e) { a0[e] = a0[e] * sigmoidf_(a0[e]) * b0[e]; a1[e] = a1[e] * sigmoidf_(a1[e]) * b1[e]; }
            st16(ACT + off, pack8(a0, a1)); } EPI_ROWS_END
    }
};

__device__ __forceinline__ void convert_tile(LAS float* tile, const float* src, int ld_src, bf16_t* dst, int ld_dst, int tk, int tn, int HALFN) {
    const int tid = threadIdx.x, j0 = tn * 256, k0 = tk * 64;
    __syncthreads();
#pragma unroll
    for (int e = 0; e < 8; ++e) { const int idx = tid + 512 * e, kk = idx >> 6, n = (idx & 63) * 4; int sc = j0 + n;
        if (HALFN) sc = (n < 128) ? tn * 128 + n : HALFN + tn * 128 + (n - 128);
        *(LAS f32x4*)(tile + kk * 260 + n) = ldnt4(src + (size_t)(k0 + kk) * ld_src + sc); }
    __syncthreads();
    const int jj = tid >> 1, kh = (tid & 1) * 32;
#pragma unroll
    for (int q = 0; q < 4; ++q) { f32x4 a, b;
#pragma unroll
        for (int e = 0; e < 4; ++e) { a[e] = tile[(kh + q * 8 + e) * 260 + jj]; b[e] = tile[(kh + q * 8 + 4 + e) * 260 + jj]; }
        *(u32x4*)(dst + (size_t)(j0 + jj) * ld_dst + k0 + kh + q * 8) = pack8(a, b); }
}

struct D2 { double s, c; };
__device__ __forceinline__ D2 sincos_turns(double turns) {
    const double f = turns - rint(turns);
    const double q = rint(f * 4.0); const int qi = ((int)q) & 3;
    const double r = (f - q * 0.25) * 6.283185307179586476925;
    const double r2 = r * r;
    double s = -1.0 / 1307674368000.0; s = s * r2 + 1.0 / 6227020800.0; s = s * r2 - 1.0 / 39916800.0; s = s * r2 + 1.0 / 362880.0; s = s * r2 - 1.0 / 5040.0; s = s * r2 + 1.0 / 120.0; s = s * r2 - 1.0 / 6.0; s = s * r2 + 1.0; s *= r;
    double c = 1.0 / 20922789888000.0; c = c * r2 - 1.0 / 87178291200.0; c = c * r2 + 1.0 / 479001600.0; c = c * r2 - 1.0 / 3628800.0; c = c * r2 + 1.0 / 40320.0; c = c * r2 - 1.0 / 720.0; c = c * r2 + 1.0 / 24.0; c = c * r2 - 0.5; c = c * r2 + 1.0;
    D2 o;
    if (qi == 0) { o.s = s; o.c = c; } else if (qi == 1) { o.s = c; o.c = -s; } else if (qi == 2) { o.s = -s; o.c = -c; } else { o.s = -c; o.c = s; }
    return o;
}

__device__ __forceinline__ void mod_item(LAS unsigned char* lds, int cgp, const float* cp, const float* cs, const float* w_ada, const float* b_ada, float* MOD) {
    const int tid = threadIdx.x, lane = tid & 63, wave = tid >> 6;
    LAS float* sc = (LAS float*)lds;
    LAS float* red = (LAS float*)(lds + 49152);
    const int cl = tid & 31, kg = tid >> 5, col = cgp * 32 + cl;
    f32x4 acc[12];
#pragma unroll
    for (int j = 0; j < 12; ++j) acc[j] = (f32x4){0.f, 0.f, 0.f, 0.f};
    for (int kc = 0; kc < 4; ++kc) {
        __syncthreads();
        for (int idx = tid; idx < 48 * 256; idx += 512) { const int bb = idx >> 8, kk = idx & 255; const float c = bb < 16 ? cp[bb * 1024 + kc * 256 + kk] : cs[(bb - 16) * 1024 + kc * 256 + kk]; sc[kk * 48 + bb] = c * sigmoidf_(c); }
        __syncthreads();
        float wv[16];
#pragma unroll
        for (int it = 0; it < 16; ++it) wv[it] = __builtin_nontemporal_load(w_ada + (size_t)(kc * 256 + kg + 16 * it) * 6144 + col);
#pragma unroll
        for (int it = 0; it < 16; ++it) { const int kk = kg + 16 * it;
#pragma unroll
            for (int j = 0; j < 12; ++j) acc[j] += *(const LAS f32x4*)(sc + kk * 48 + 4 * j) * wv[it]; }
    }
#pragma unroll
    for (int j = 0; j < 12; ++j)
#pragma unroll
        for (int e = 0; e < 4; ++e) acc[j][e] += __shfl_xor(acc[j][e], 32);
    __syncthreads();
    if (lane < 32) {
#pragma unroll
        for (int j = 0; j < 12; ++j)
#pragma unroll
            for (int e = 0; e < 4; ++e) red[(wave * 48 + 4 * j + e) * 32 + cl] = acc[j][e];
    }
    __syncthreads();
    for (int o = tid; o < 1536; o += 512) { const int bb = o >> 5, c2 = o & 31; float s = b_ada[cgp * 32 + c2];
#pragma unroll
        for (int w = 0; w < 8; ++w) s += red[(w * 48 + bb) * 32 + c2];
        MOD[(size_t)bb * 6144 + cgp * 32 + c2] = s; }
    __syncthreads();
}

__device__ __forceinline__ void ssm_tables(LAS unsigned char* lds, int g, int sl, const Params& p, float* KTAB, float* ABT, bf16_t* WE, bf16_t* WY) {
    const int tid = threadIdx.x;
    LAS float* PW = (LAS float*)lds;
    LAS float* BB = (LAS float*)(lds + 33280);
    LAS float* CC = (LAS float*)(lds + 33280 + 8192);
    LAS float* FF = (LAS float*)(lds + 33280 + 16384);
    const float* a_re = p.in[12] + g * 64; const float* a_im = p.in[13] + g * 64;
    const double dt = exp((double)p.in[14][g]);
    __syncthreads();
    for (int idx = tid; idx < 64 * 65; idx += 512) { const int pp = idx / 65, d = idx % 65; const double lr = dt * (double)a_re[pp], li = dt * (double)a_im[pp];
        const double mag = exp((double)d * lr); const D2 sc = sincos_turns((double)d * li * 0.15915494309189533577);
        PW[idx * 2] = (float)(mag * sc.c); PW[idx * 2 + 1] = (float)(mag * sc.s); }
    if (tid < 64) { const int pp = tid; const double are = a_re[pp], aim = a_im[pp];
        const double mag = exp(dt * are); const D2 sc = sincos_turns(dt * aim * 0.15915494309189533577);
        const double abr = mag * sc.c, abi = mag * sc.s, den = are * are + aim * aim, nre = abr - 1.0;
        FF[pp * 2] = (float)((nre * are + abi * aim) / den); FF[pp * 2 + 1] = (float)((abi * are - nre * aim) / den); }
    for (int idx = tid; idx < 1024; idx += 512) { CC[idx * 2] = p.in[17][g * 1024 + idx]; CC[idx * 2 + 1] = p.in[18][g * 1024 + idx]; }
    __syncthreads();
    for (int idx = tid; idx < 1024; idx += 512) { const int pp = idx >> 4; const float fre = FF[pp * 2], fim = FF[pp * 2 + 1];
        const float br = p.in[15][g * 1024 + idx], bi = p.in[16][g * 1024 + idx];
        BB[idx * 2] = fre * br - fim * bi; BB[idx * 2 + 1] = fre * bi + fim * br; }
    __syncthreads();
    { const int m = (tid >> 4) & 15, mm = tid & 15, d0 = sl * 8 + (tid >> 8) * 4; float a4[4] = {0.f, 0.f, 0.f, 0.f};
        for (int pp = 0; pp < 64; ++pp) { const f32x2 c = *(const LAS f32x2*)(CC + (m * 64 + pp) * 2), bq = *(const LAS f32x2*)(BB + (pp * 16 + mm) * 2);
            const float cbr = c[0] * bq[0] - c[1] * bq[1], cbi = c[0] * bq[1] + c[1] * bq[0];
#pragma unroll
            for (int q = 0; q < 4; ++q) { const f32x2 pw = *(const LAS f32x2*)(PW + (pp * 65 + d0 + q) * 2); a4[q] += cbr * pw[0] - cbi * pw[1]; } }
#pragma unroll
        for (int q = 0; q < 4; ++q) { const int d = d0 + q; float v = a4[q]; if (d == 0 && m == mm) v += p.in[19][g * 16 + m]; KTAB[(size_t)g * 16384 + d * 256 + m * 16 + mm] = v; } }
    for (int o = tid; o < 128 * 16; o += 512) { const int q = o >> 4, k0 = sl * 128 + (o & 15) * 8, j = k0 >> 4, m0 = k0 & 15, pp = q & 63;
        const float pr = PW[(pp * 65 + 63 - j) * 2], pi = PW[(pp * 65 + 63 - j) * 2 + 1]; f32x4 a, b;
#pragma unroll
        for (int e = 0; e < 8; ++e) { const float br = BB[(pp * 16 + m0 + e) * 2], bi = BB[(pp * 16 + m0 + e) * 2 + 1]; const float v = (q < 64) ? pr * br - pi * bi : pr * bi + pi * br; if (e < 4) a[e] = v; else b[e - 4] = v; }
        *(u32x4*)(WE + ((size_t)(g * 128 + q)) * 1024 + k0) = pack8(a, b); }
    for (int o = tid; o < 128 * 16; o += 512) { const int n = sl * 128 + (o >> 4), k0 = (o & 15) * 8, i = n >> 4, m = n & 15; f32x4 a, b;
#pragma unroll
        for (int e = 0; e < 8; ++e) { const int k = k0 + e, pp = k & 63; const float cr = CC[(m * 64 + pp) * 2], ci = CC[(m * 64 + pp) * 2 + 1], pr = PW[(pp * 65 + i + 1) * 2], pi = PW[(pp * 65 + i + 1) * 2 + 1];
            const float v = (k < 64) ? cr * pr - ci * pi : -(cr * pi + ci * pr); if (e < 4) a[e] = v; else b[e - 4] = v; }
        *(u32x4*)(WY + ((size_t)(g * 1024 + n)) * UK + k0) = pack8(a, b); }
    if (sl == 0 && tid < 64) { ABT[(g * 64 + tid) * 2] = PW[(tid * 65 + 64) * 2]; ABT[(g * 64 + tid) * 2 + 1] = PW[(tid * 65 + 64) * 2 + 1]; }
    __syncthreads();
}

__device__ __forceinline__ void ln_row(f32x4 (&v)[4]) {
    float s = 0.f;
#pragma unroll
    for (int i = 0; i < 4; ++i) s += v[i][0] + v[i][1] + v[i][2] + v[i][3];
    const float mean = wave_sum(s) * (1.0f / 1024.0f);
    float q = 0.f;
#pragma unroll
    for (int i = 0; i < 4; ++i)
#pragma unroll
        for (int e = 0; e < 4; ++e) { v[i][e] -= mean; q += v[i][e] * v[i][e]; }
    const float rstd = rsqrtf(wave_sum(q) * (1.0f / 1024.0f) + 1e-5f);
#pragma unroll
    for (int i = 0; i < 4; ++i) v[i] *= rstd;
}

__device__ __forceinline__ float rows_max(float x) {
    float a = x, b = x;
    asm volatile("v_nop\n\tv_nop\n\tv_permlane16_swap_b32 %0, %1" : "+v"(a), "+v"(b));
    a = fmaxf(a, b); b = a;
    asm volatile("v_nop\n\tv_nop\n\tv_permlane32_swap_b32 %0, %1" : "+v"(a), "+v"(b));
    return fmaxf(a, b);
}
__device__ __forceinline__ float rows_sum(float x) {
    float a = x, b = x;
    asm volatile("v_nop\n\tv_nop\n\tv_permlane16_swap_b32 %0, %1" : "+v"(a), "+v"(b));
    a = a + b; b = a;
    asm volatile("v_nop\n\tv_nop\n\tv_permlane32_swap_b32 %0, %1" : "+v"(a), "+v"(b));
    return a + b;
}

__device__ __forceinline__ void attn_phase(LAS unsigned char* lds, int vb, const float* rel_bias, const bf16_t* Q, const bf16_t* KP, const bf16_t* KS, const bf16_t* VT, const bf16_t* VTS, bf16_t* OATT) {
    const int tid = threadIdx.x, lane = tid & 63, h = __builtin_amdgcn_readfirstlane(tid >> 6), fr = lane & 15, g = lane >> 4;
    LAS float* bias2 = (LAS float*)lds;
    __syncthreads();
    for (int i = tid; i < 8 * 640; i += 512) { const int hh = i / 640, d = i % 640 - 63; const int dc = d < -256 ? -256 : (d > 256 ? 256 : d); bias2[i] = rel_bias[hh * 513 + dc + 256] * LOG2E; }
    __syncthreads();
    const LAS float* bh = bias2 + h * 640 + 63;
    LAS unsigned char* vl = lds + 20480 + h * 4096;
    const float sc = 0.125f * LOG2E;
    const int G = gridDim.x, crev = G - 1 - vb;
    for (int L = crev; L < 544; L += G) {
        int qrow0, nk; const bf16_t* kbase; const bf16_t* vbase;
        if (L < 32) { const int b = L; qrow0 = MP + b * 64; nk = 576; kbase = KS + (size_t)b * KSL * 512 + h * 64; vbase = VTS + (size_t)b * KSL * 512 + h * 64; }
        else { const int L2 = L - 32; int c, b; if (L2 < 384) { b = L2 / 24; c = 8 + L2 % 24; } else { const int L3 = L2 - 384; c = 7 - (L3 >> 4); b = L3 & 15; } qrow0 = b * 2048 + c * 64; nk = (c < 8 ? c + 1 : 9) * 64;
            const int k0 = (c + 1) * 64 - nk; kbase = KP + ((size_t)(b * 2048 + k0)) * 512 + h * 64; vbase = VT + ((size_t)(b * 2048 + k0)) * 512 + h * 64; }
        bf16x8 Qf[4][2];
#pragma unroll
        for (int qb = 0; qb < 4; ++qb)
#pragma unroll
            for (int ks = 0; ks < 2; ++ks) Qf[qb][ks] = *(const bf16x8*)(Q + ((size_t)(qrow0 + qb * 16 + fr)) * 512 + h * 64 + ks * 32 + g * 8);
        f32x4 O[4][4]; float mrow[4], lrow[4];
#pragma unroll
        for (int a = 0; a < 4; ++a) { mrow[a] = -INFINITY; lrow[a] = 0.f;
#pragma unroll
            for (int b = 0; b < 4; ++b) O[a][b] = (f32x4){0.f, 0.f, 0.f, 0.f}; }
        const int ntile = nk >> 5;
        const int krow = 8 * (fr >> 2) + (fr & 3);
        bf16x8 Kf[2][2], Vf[4];
#pragma unroll
        for (int kb = 0; kb < 2; ++kb)
#pragma unroll
            for (int ks = 0; ks < 2; ++ks) Kf[kb][ks] = *(const bf16x8*)(kbase + ((size_t)(krow + 4 * kb)) * 512 + ks * 32 + g * 8);
#pragma unroll
        for (int i = 0; i < 4; ++i) Vf[i] = *(const bf16x8*)(vbase + (size_t)((i * 64 + lane) >> 3) * 512 + (lane & 7) * 8);
        for (int t = 0; t < ntile; ++t) {
            f32x4 S[2][4];
#pragma unroll
            for (int kb = 0; kb < 2; ++kb)
#pragma unroll
                for (int qb = 0; qb < 4; ++qb) { f32x4 s = (f32x4){0.f, 0.f, 0.f, 0.f};
#pragma unroll
                    for (int ks = 0; ks < 2; ++ks) s = __builtin_amdgcn_mfma_f32_16x16x32_bf16(Kf[kb][ks], Qf[qb][ks], s, 0, 0, 0);
                    S[kb][qb] = s; }
            if (t + 1 < ntile) {
#pragma unroll
                for (int kb = 0; kb < 2; ++kb)
#pragma unroll
                    for (int ks = 0; ks < 2; ++ks) Kf[kb][ks] = *(const bf16x8*)(kbase + ((size_t)((t + 1) * 32 + krow + 4 * kb)) * 512 + ks * 32 + g * 8);
            }
            bf16x8 Pf[4];
            float sv[4][2][4], mx[4];
#pragma unroll
            for (int qb = 0; qb < 4; ++qb) {
                const int dbase = qb * 16 + fr + nk - 64 - t * 32 - 8 * g; float m_ = -INFINITY;
#pragma unroll
                for (int kb = 0; kb < 2; ++kb)
#pragma unroll
                    for (int r = 0; r < 4; ++r) { const float v = S[kb][qb][r] * sc + bh[dbase - 4 * kb - r]; sv[qb][kb][r] = v; m_ = fmaxf(m_, v); }
                mx[qb] = m_;
            }
#pragma unroll
            for (int qb = 0; qb < 4; ++qb) mx[qb] = rows_max(mx[qb]);
#pragma unroll
            for (int qb = 0; qb < 4; ++qb) {
                if (__builtin_amdgcn_ballot_w64(mx[qb] - mrow[qb] > 11.0f) != 0ull) {
                    const float mnew = fmaxf(mrow[qb], mx[qb]); const float alpha = __builtin_amdgcn_exp2f(mrow[qb] - mnew); mrow[qb] = mnew; lrow[qb] *= alpha;
#pragma unroll
                    for (int hb = 0; hb < 4; ++hb) O[hb][qb] *= alpha;
                }
                const float mcur = mrow[qb]; float ps = 0.f;
#pragma unroll
                for (int kb = 0; kb < 2; ++kb)
#pragma unroll
                    for (int r = 0; r < 4; ++r) { sv[qb][kb][r] = __builtin_amdgcn_exp2f(sv[qb][kb][r] - mcur); ps += sv[qb][kb][r]; }
                lrow[qb] += ps;
                u32x4 pk; pk[0] = cvt_pk_bf16(sv[qb][0][0], sv[qb][0][1]); pk[1] = cvt_pk_bf16(sv[qb][0][2], sv[qb][0][3]); pk[2] = cvt_pk_bf16(sv[qb][1][0], sv[qb][1][1]); pk[3] = cvt_pk_bf16(sv[qb][1][2], sv[qb][1][3]);
                Pf[qb] = __builtin_bit_cast(bf16x8, pk);
            }
            __builtin_amdgcn_wave_barrier();
#pragma unroll
            for (int i = 0; i < 4; ++i) *(LAS bf16x8*)(vl + ((i * 64 + lane) >> 3) * 128 + (lane & 7) * 16) = Vf[i];
            __builtin_amdgcn_fence(__ATOMIC_RELEASE, "wavefront"); __builtin_amdgcn_wave_barrier();
            bf16x8 Vt[4];
#pragma unroll
            for (int hb = 0; hb < 4; ++hb)
#pragma unroll
                for (int j = 0; j < 8; ++j) Vt[hb][j] = *(const LAS short*)(vl + (8 * g + j) * 128 + (hb * 16 + fr) * 2);
#pragma unroll
            for (int hb = 0; hb < 4; ++hb)
#pragma unroll
                for (int qb = 0; qb < 4; ++qb) O[hb][qb] = __builtin_amdgcn_mfma_f32_16x16x32_bf16(Vt[hb], Pf[qb], O[hb][qb], 0, 0, 0);
            if (t + 1 < ntile) {
#pragma unroll
                for (int i = 0; i < 4; ++i) Vf[i] = *(const bf16x8*)(vbase + (size_t)((t + 1) * 32 + ((i * 64 + lane) >> 3)) * 512 + (lane & 7) * 8);
            }
        }
#pragma unroll
        for (int qb = 0; qb < 4; ++qb) { const float l = rows_sum(lrow[qb]); const float inv = 1.0f / l;
#pragma unroll
            for (int hb = 0; hb < 4; ++hb) { const f32x4 o = O[hb][qb] * inv; u32x2 pk; pk[0] = cvt_pk_bf16(o[0], o[1]); pk[1] = cvt_pk_bf16(o[2], o[3]);
                *(u32x2*)(OATT + ((size_t)(qrow0 + qb * 16 + fr)) * 512 + h * 64 + hb * 16 + 4 * g) = pk; } }
    }
}

#define XB_TMO      128
#define XB_XCNT(j)  (256  + 64 * (j))
#define XB_XSUB(j)  (1280 + 64 * (j))
#define XB_XGEN(j)  (2304 + 64 * (j))
#define XB_TOP      3328
#define XB_TOPGEN   3392
#define XCD_BAR_WORDS 3456
#define XB_SPIN_CAP (1u << 18)

__device__ __forceinline__ unsigned xb_ld(unsigned* p)              { return __hip_atomic_load(p, __ATOMIC_RELAXED, __HIP_MEMORY_SCOPE_AGENT); }
__device__ __forceinline__ unsigned xb_add(unsigned* p, unsigned v) { return __hip_atomic_fetch_add(p, v, __ATOMIC_RELAXED, __HIP_MEMORY_SCOPE_AGENT); }
__device__ __forceinline__ unsigned xb_xcc_id() { return (unsigned)__builtin_amdgcn_s_getreg((3 << 11) | 20) & 0xFu; }
#define XB_SPIN(cond, bar) do { unsigned _sp = 0; while (cond) { __builtin_amdgcn_s_sleep(1); \
    if ((++_sp & 255u) == 0u) { if (xb_ld(&(bar)[XB_TMO])) break; if (_sp > XB_SPIN_CAP) { atomicAdd(&(bar)[XB_TMO], 1u); break; } } } } while (0)

struct XcdBarrier {
    unsigned* bar; unsigned x;
    volatile LAS unsigned* st;
};

__device__ __forceinline__ XcdBarrier xcd_barrier_post(unsigned* bar, volatile LAS unsigned* st) {
    XcdBarrier b; b.bar = bar; b.x = xb_xcc_id(); b.st = st;
    if (threadIdx.x == 0) st[2] = xb_add(&bar[XB_XCNT(b.x)], 1u);
    return b;
}
__device__ __forceinline__ void xcd_barrier_complete(unsigned* bar, unsigned x, unsigned& nloc, unsigned& nx) {
    const unsigned G = gridDim.x * gridDim.y * gridDim.z;
    unsigned sum, cnt, mine, sp = 0u;
    for (;;) {
        sum = 0u; cnt = 0u; mine = 0u;
#pragma unroll
        for (unsigned j = 0; j < 16; ++j) { const unsigned c = xb_ld(&bar[XB_XCNT(j)]); sum += c; cnt += (c > 0u) ? 1u : 0u; mine = (j == x) ? c : mine; }
        if (sum == G) break;
        __builtin_amdgcn_s_sleep(1);
        if ((++sp & 255u) == 0u) { if (xb_ld(&bar[XB_TMO])) break; if (sp > XB_SPIN_CAP) { atomicAdd(&bar[XB_TMO], 1u); break; } }
    }
    nloc = mine > 0u ? mine : 1u; nx = cnt > 0u ? cnt : 1u;
}

__device__ __forceinline__ void xcd_barrier(const XcdBarrier& b) {
    asm volatile("s_waitcnt vmcnt(0)" ::: "memory");
    __syncthreads();
    if (threadIdx.x == 0) {
        unsigned* bar = b.bar;
        __builtin_amdgcn_s_waitcnt(0);
        unsigned nloc = b.st[0], nx = b.st[1];
        if (nloc == 0u) { xcd_barrier_complete(bar, b.x, nloc, nx); b.st[0] = nloc; b.st[1] = nx; }
        const unsigned old = xb_add(&bar[XB_XSUB(b.x)], 1u);
        const unsigned gen = old / nloc;
        if (old + 1u == (gen + 1u) * nloc) {
            __builtin_amdgcn_fence(__ATOMIC_RELEASE, "agent");
            asm volatile("s_waitcnt vmcnt(0)" ::: "memory");
            const unsigned og = xb_add(&bar[XB_TOP], 1u);
            const unsigned tg = og / nx;
            if (og + 1u == (tg + 1u) * nx) xb_add(&bar[XB_TOPGEN], 1u);
            else XB_SPIN(xb_ld(&bar[XB_TOPGEN]) == tg, bar);
            __builtin_amdgcn_fence(__ATOMIC_ACQUIRE, "agent");
            xb_add(&bar[XB_XGEN(b.x)], 1u);
            asm volatile("s_waitcnt vmcnt(0)" ::: "memory");
        } else {
            XB_SPIN(xb_ld(&bar[XB_XGEN(b.x)]) == gen, bar);
            __builtin_amdgcn_fence(__ATOMIC_ACQUIRE, "agent");
            asm volatile("s_waitcnt vmcnt(0)" ::: "memory");
        }
    }
    __syncthreads();
}


__device__ __forceinline__ int ln_row_of(int k, int w, int np, int ns) { if (k < np) { const int r = w * np + k; return r < MP ? r : -1; } const int r = w * ns + (k - np); return r < MS ? MP + r : -1; }

__global__ void __launch_bounds__(512, 2) mega(Params p) {
    extern __shared__ __attribute__((aligned(16))) unsigned char smem[];
    LAS unsigned char* lds = (LAS unsigned char*)smem;
    const int tid = threadIdx.x, lane = tid & 63, wave = tid >> 6, G = gridDim.x, bid = blockIdx.x;
    unsigned char* ws = p.ws; float* out = p.out;
    float* MOD = (float*)(ws + W_MOD);
    bf16_t* WIN = (bf16_t*)(ws + W_WIN); bf16_t* WAP = (bf16_t*)(ws + W_WAP); bf16_t* WGLU = (bf16_t*)(ws + W_WGLU); bf16_t* WOUT = (bf16_t*)(ws + W_WOUT);
    bf16_t* WFI = (bf16_t*)(ws + W_WFI); bf16_t* WFO = (bf16_t*)(ws + W_WFO);
    float* KTAB = (float*)(ws + W_KTAB); float* ABT = (float*)(ws + W_ABT); bf16_t* WE = (bf16_t*)(ws + W_WE);
    bf16_t* WY = (bf16_t*)(ws + W_WY); bf16_t* UG = (bf16_t*)(ws + W_UG); float* EBUF = (float*)(ws + W_EBUF);
    bf16_t* H = (bf16_t*)(ws + W_H); bf16_t* Qb = (bf16_t*)(ws + W_Q); bf16_t* KP = (bf16_t*)(ws + W_KP); bf16_t* KS = (bf16_t*)(ws + W_KS);
    bf16_t* VT = (bf16_t*)(ws + W_VT); bf16_t* VTS = (bf16_t*)(ws + W_VTS); bf16_t* GY = (bf16_t*)(ws + W_GY);
    bf16_t* X1b = (bf16_t*)(ws + W_X1); float* TS1 = (float*)(ws + W_Q); float* TS2 = (float*)(ws + W_X1 + 71303168); bf16_t* MIX = (bf16_t*)(ws + W_MIX); bf16_t* OATT = (bf16_t*)(ws + W_OATT); bf16_t* P1 = (bf16_t*)(ws + W_P1); bf16_t* ACT = (bf16_t*)(ws + W_ACT);
    unsigned char* GA = (unsigned char*)out; unsigned char* GB = GA + (size_t)MT * 1024;
    cg::grid_group grid = cg::this_grid();
    int vb = (G % 8 == 0) ? (bid % 8) * (G / 8) + bid / 8 : bid;
    int cb = bid;
#ifndef ONLY
#define ONLY -1
#endif
#ifndef REPMASK
#define REPMASK 0
#endif
#define PHASE(k) if ((ONLY < 0 || ONLY == (k)) && p.ph_lo <= (k) && (k) < p.ph_hi) for (int rep_ = 0; rep_ <= ((REPMASK >> (k)) & 1); ++rep_)
#define REPSYNC if (rep_) grid.sync();
    volatile LAS unsigned* bst = (volatile LAS unsigned*)(lds + 131072);
    if (tid < 4) bst[tid] = 0u;
    __syncthreads();
    XcdBarrier xbar = xcd_barrier_post((unsigned*)(ws + W_BAR), bst);
#define SEAM(k) if (p.ph_lo < (k) && (k) < p.ph_hi) { if (p.ph_hi > 1000) grid.sync(); else xcd_barrier(xbar); }

    PHASE(0) { REPSYNC
        for (int w = vb; w < 256; w += G) {
            if (w < 192) mod_item(lds, w, p.in[2], p.in[3], p.in[8], p.in[9], MOD);
            ssm_tables(lds, w >> 3, w & 7, p, KTAB, ABT, WE, WY);
        }
        LAS float* tile = (LAS float*)lds;
        for (int t = vb; t < 944; t += G) {
            if (t < 256) convert_tile(tile, p.in[10], 4096, WIN, 1024, t % 16, t / 16, 0);
            else if (t < 288) { const int q = t - 256; convert_tile(tile, p.in[20], 1024, WAP, 512, q % 8, q / 8, 0); }
            else if (t < 352) { const int q = t - 288; convert_tile(tile, p.in[21], 2048, WGLU, 512, q % 8, q / 8, 1024); }
            else if (t < 416) { const int q = t - 352; convert_tile(tile, p.in[22], 1024, WOUT, 1024, q % 16, q / 16, 0); }
            else if (t < 768) { const int q = t - 416; convert_tile(tile, p.in[25], 5632, WFI, 1024, q % 16, q / 16, 2816); }
            else { const int q = t - 768; convert_tile(tile, p.in[26], 1024, WFO, 2816, q % 44, q / 44, 0); }
        }
        for (size_t idx = (size_t)bid * 512 + tid; idx < (size_t)32 * 512 * 64; idx += (size_t)G * 512) { const size_t row = idx >> 6; const int c8 = (int)(idx & 63) * 8; const int b = (int)(row >> 9), pos = (int)(row & 511);
            const float* s = p.in[4] + row * 512 + c8; const float* s2 = p.in[5] + row * 512 + c8; const f32x4 k0 = ldnt4(s), k1 = ldnt4(s + 4), v0 = ldnt4(s2), v1 = ldnt4(s2 + 4);
            *(u32x4*)(KS + ((size_t)(b * KSL + pos)) * 512 + c8) = pack8(k0, k1); *(u32x4*)(VTS + ((size_t)(b * KSL + pos)) * 512 + c8) = pack8(v0, v1); }
    }
    SEAM(1)
    if (p.ph_lo < 1 && 1 < p.ph_hi && G % 8 == 0) {
        if (tid == 0) { unsigned base = 0; for (unsigned j = 0; j < 16; ++j) { const unsigned cnt = xb_ld((unsigned*)(ws + W_BAR) + XB_XCNT(j)); if (j < xbar.x) base += cnt; } bst[3] = base + bst[2]; }
        __syncthreads();
        vb = (int)bst[3]; cb = (vb % (G / 8)) * 8 + vb / (G / 8);
        __syncthreads();
    }
    PHASE(1) { REPSYNC
        { const int rpw = (MT + G * 8 - 1) / (G * 8); const int rbeg = (bid * 8 + wave) * rpw; const int rend = rbeg + rpw < MT ? rbeg + rpw : MT;
          int cur_mr = -1; f32x4 sh[4], sc[4];
          for (int r0 = rbeg; r0 < rend; r0 += 8) {
            f32x4 v[8][4];
#pragma unroll
            for (int q = 0; q < 8; ++q) { const int r = r0 + q < rend ? r0 + q : rend - 1; const float* xr = (r < MP) ? p.in[0] + (size_t)r * 1024 : p.in[1] + (size_t)(r - MP) * 1024;
#pragma unroll
                for (int i = 0; i < 4; ++i) v[q][i] = ldnt4(xr + i * 256 + lane * 4); }
#pragma unroll
            for (int q = 0; q < 8; ++q) { const int r = r0 + q; if (r < rend) {
                const int mr = modrow_of(r);
                if (mr != cur_mr) { cur_mr = mr; const float* md = MOD + (size_t)mr * 6144;
#pragma unroll
                    for (int i = 0; i < 4; ++i) { sh[i] = *(const f32x4*)(md + i * 256 + lane * 4); sc[i] = *(const f32x4*)(md + 1024 + i * 256 + lane * 4); } }
                ln_row(v[q]);
#pragma unroll
                for (int i = 0; i < 4; ++i) { const int col = i * 256 + lane * 4; const f32x4 hv = v[q][i] * (1.0f + sc[i]) + sh[i];
                    u32x2 pk; pk[0] = cvt_pk_bf16(hv[0], hv[1]); pk[1] = cvt_pk_bf16(hv[2], hv[3]); *(u32x2*)(H + (size_t)r * 1024 + col) = pk; } } }
          } }
    }
    SEAM(2)
    PHASE(2) { REPSYNC
        pg8::TileSched S; S.init(MT, 4096, 1024, G, cb);
        EpiIn E{Qb, KP, KS, VT, VTS, UG, GA, GB, out};
        pg8::gemm_phase(lds, H, 1024, WIN, 1024, S, E);
        const bool half = (G == 256); const int wyn = half ? 128 : G, wyb = half ? cb - 128 : bid;
        if (wyb >= 0) {
        for (size_t idx0 = (size_t)wyb * 512 + tid; idx0 < (size_t)32 * 1024 * 128; idx0 += (size_t)wyn * 512 * 4) {
            f32x4 ka[4], kb[4]; bool nz[4];
#pragma unroll
            for (int q = 0; q < 4; ++q) { const size_t idx = idx0 + (size_t)q * wyn * 512; nz[q] = false;
                if (idx < (size_t)32 * 1024 * 128) { const int g = (int)(idx >> 17), n = (int)(idx >> 7) & 1023, k0 = (int)(idx & 127) * 8; const int j = k0 >> 4, m0 = k0 & 15, i = n >> 4, m = n & 15;
                    if (i >= j) { nz[q] = true; const float* s = KTAB + (size_t)g * 16384 + (i - j) * 256 + m * 16 + m0; ka[q] = *(const f32x4*)s; kb[q] = *(const f32x4*)(s + 4); } } }
#pragma unroll
            for (int q = 0; q < 4; ++q) { const size_t idx = idx0 + (size_t)q * wyn * 512;
                if (idx < (size_t)32 * 1024 * 128) { const int g = (int)(idx >> 17), n = (int)(idx >> 7) & 1023, k0 = (int)(idx & 127) * 8;
                    *(u32x4*)(WY + ((size_t)(g * 1024 + n)) * UK + 128 + k0) = nz[q] ? pack8(ka[q], kb[q]) : (u32x4){0u, 0u, 0u, 0u}; } }
        }
        }
    }
    SEAM(3)
    PHASE(3) { REPSYNC
        { pg8::ESched S{G, vb}; EpiE E{EBUF}; pg8::gemm_phase(lds, UG + 128, UK, WE, 1024, S, E); }
        attn_phase(lds, vb, p.in[11], Qb, KP, KS, VT, VTS, OATT);
    }
    SEAM(4)
    PHASE(4) { REPSYNC
        for (int idx = bid * 512 + tid; idx < 98304; idx += G * 512) {
            const bool prm = idx < 32768; const int i2 = prm ? idx : idx - 32768; const int b = i2 >> 11, g = (i2 >> 6) & 31, pp = i2 & 63;
            const float ar = ABT[(g * 64 + pp) * 2], ai = ABT[(g * 64 + pp) * 2 + 1];
            if (prm) { float sr = 0.f, si = 0.f; float er[32], ei[32];
#pragma unroll
                for (int c = 0; c < 32; ++c) { const size_t row = (size_t)g * 768 + b * 32 + c; er[c] = EBUF[row * 128 + pp]; ei[c] = EBUF[row * 128 + 64 + pp]; }
#pragma unroll
                for (int c = 0; c < 32; ++c) { const size_t row = (size_t)g * 768 + b * 32 + c; UG[row * UK + pp] = (bf16_t)(cvt_pk_bf16(sr, 0.f) & 0xffffu); UG[row * UK + 64 + pp] = (bf16_t)(cvt_pk_bf16(si, 0.f) & 0xffffu);
                    const float nr = ar * sr - ai * si + er[c], ni = ar * si + ai * sr + ei[c]; sr = nr; si = ni; }
                out[O_SRP + (size_t)(b * 32 + g) * 64 + pp] = sr; out[O_SIP + (size_t)(b * 32 + g) * 64 + pp] = si; }
            else { float sr = p.in[6][(size_t)(b * 32 + g) * 64 + pp], si = p.in[7][(size_t)(b * 32 + g) * 64 + pp]; const size_t row = (size_t)g * 768 + 512 + b;
                UG[row * UK + pp] = (bf16_t)(cvt_pk_bf16(sr, 0.f) & 0xffffu); UG[row * UK + 64 + pp] = (bf16_t)(cvt_pk_bf16(si, 0.f) & 0xffffu);
                const float er = EBUF[row * 128 + pp], ei = EBUF[row * 128 + 64 + pp]; const float nr = ar * sr - ai * si + er, ni = ar * si + ai * sr + ei;
                out[O_SRS + (size_t)(b * 32 + g) * 64 + pp] = nr; out[O_SIS + (size_t)(b * 32 + g) * 64 + pp] = ni; }
        }
    }
    SEAM(5)
    PHASE(5) { REPSYNC
        { pg8::YSched S{G, vb}; EpiY E{GY}; pg8::gemm_phase(lds, UG, UK, WY, UK, S, E); }
        { pg8::APSched S{G, vb}; EpiAP E{GA, P1}; pg8::gemm_phase(lds, OATT, 512, WAP, 512, S, E); }
    }
    SEAM(6)
    PHASE(6) { REPSYNC pg8::TileSched S; S.init(MT, 2048, 512, G, cb); EpiGLU E{GB, P1, MIX}; pg8::gemm_phase(lds, GY, 512, WGLU, 512, S, E); }
    SEAM(7)
    PHASE(7) { REPSYNC pg8::ResSched S{G, vb, 16, 4}; EpiRes<false> E{p.in[0], p.in[1], nullptr, MOD, (bf16_t*)out, TS1, 2048}; pg8::gemm_phase<true>(lds, MIX, 64, WOUT, 1024, S, E, 16); }
    SEAM(8)
    PHASE(8) { REPSYNC
        const int NW = G * 8, wg_ = bid * 8 + wave, np_ = (MP + NW - 1) / NW, ns_ = (MS + NW - 1) / NW, ntot = np_ + ns_;
        int cur_mr = -1; f32x4 sh[4], sc[4], lg[4], lb[4];
#pragma unroll
        for (int i = 0; i < 4; ++i) { lg[i] = *(const f32x4*)(p.in[23] + i * 256 + lane * 4); lb[i] = *(const f32x4*)(p.in[24] + i * 256 + lane * 4); }
        for (int k0 = 0; k0 < ntot; k0 += 6) {
            f32x4 v[6][4];
#pragma unroll
            for (int q = 0; q < 6; ++q) { const int rr = (k0 + q < ntot) ? ln_row_of(k0 + q, wg_, np_, ns_) : -1; const int r = rr < 0 ? 0 : rr;
#pragma unroll
                for (int i = 0; i < 4; ++i) { if (r < MP) { const u32x2 t = ldnt2((const bf16_t*)out + (size_t)r * 1024 + i * 256 + lane * 4); v[q][i] = (f32x4){bf_lo(t[0]), bf_hi(t[0]), bf_lo(t[1]), bf_hi(t[1])}; }
                    else { const float* tp = TS1 + (size_t)(r - MP) * 1024 + i * 256 + lane * 4; f32x4 a = *(const f32x4*)tp;
                        if (G == 256) { for (int sl = 1; sl < 4; ++sl) a += *(const f32x4*)(tp + (size_t)sl * 2048 * 1024); } v[q][i] = a; } } }
#pragma unroll
            for (int q = 0; q < 6; ++q) { const int r = (k0 + q < ntot) ? ln_row_of(k0 + q, wg_, np_, ns_) : -1; if (r >= 0) {
                const int mr = modrow_of(r);
                if (mr != cur_mr) { cur_mr = mr; const float* md = MOD + (size_t)mr * 6144;
#pragma unroll
                    for (int i = 0; i < 4; ++i) { sh[i] = *(const f32x4*)(md + 3072 + i * 256 + lane * 4); sc[i] = *(const f32x4*)(md + 4096 + i * 256 + lane * 4); } }
                ln_row(v[q]);
#pragma unroll
                for (int i = 0; i < 4; ++i) { const int col = i * 256 + lane * 4; v[q][i] = v[q][i] * lg[i] + lb[i]; u32x2 pk; pk[0] = cvt_pk_bf16(v[q][i][0], v[q][i][1]); pk[1] = cvt_pk_bf16(v[q][i][2], v[q][i][3]); *(u32x2*)(X1b + (size_t)r * 1024 + col) = pk; }
                ln_row(v[q]);
#pragma unroll
                for (int i = 0; i < 4; ++i) { const int col = i * 256 + lane * 4; const f32x4 hv = v[q][i] * (1.0f + sc[i]) + sh[i];
                    u32x2 pk; pk[0] = cvt_pk_bf16(hv[0], hv[1]); pk[1] = cvt_pk_bf16(hv[2], hv[3]); *(u32x2*)(H + (size_t)r * 1024 + col) = pk; } } }
        }
    }
    SEAM(9)
    PHASE(9) { REPSYNC pg8::TileSched S; S.init(MT, 5632, 1024, G, cb); EpiFI E{ACT}; pg8::gemm_phase(lds, H, 1024, WFI, 1024, S, E); }
    SEAM(10)
    PHASE(10) { REPSYNC pg8::ResSched S{G, vb, 44, 8}; EpiRes<true> E{nullptr, nullptr, X1b, MOD, H, TS2, 5120}; pg8::gemm_phase<true>(lds, ACT, 64, WFO, DFF, S, E, 44); }
    SEAM(11)
    PHASE(11) { REPSYNC
        const int NW = G * 8, wg_ = bid * 8 + wave, np_ = (MP + NW - 1) / NW, ns_ = (MS + NW - 1) / NW, ntot = np_ + ns_;
        f32x4 lg[4], lb[4];
#pragma unroll
        for (int i = 0; i < 4; ++i) { lg[i] = *(const f32x4*)(p.in[27] + i * 256 + lane * 4); lb[i] = *(const f32x4*)(p.in[28] + i * 256 + lane * 4); }
        for (int k0 = 0; k0 < ntot; k0 += 8) {
            f32x4 v[8][4];
#pragma unroll
            for (int q = 0; q < 8; ++q) { const int rr = (k0 + q < ntot) ? ln_row_of(k0 + q, wg_, np_, ns_) : -1; const int r = rr < 0 ? 0 : rr;
#pragma unroll
                for (int i = 0; i < 4; ++i) { if (r < MP) { const u32x2 t = ldnt2(H + (size_t)r * 1024 + i * 256 + lane * 4); v[q][i] = (f32x4){bf_lo(t[0]), bf_hi(t[0]), bf_lo(t[1]), bf_hi(t[1])}; }
                    else { const float* tp = TS2 + (size_t)(r - MP) * 1024 + i * 256 + lane * 4; f32x4 a = *(const f32x4*)tp;
                        if (G == 256) { for (int sl = 1; sl < 8; ++sl) a += *(const f32x4*)(tp + (size_t)sl * 2048 * 1024); } v[q][i] = a; } } }
#pragma unroll
            for (int q = 0; q < 8; ++q) { const int r = (k0 + q < ntot) ? ln_row_of(k0 + q, wg_, np_, ns_) : -1; if (r >= 0) {
                ln_row(v[q]);
#pragma unroll
                for (int i = 0; i < 4; ++i) { const int col = i * 256 + lane * 4; stnt4(out + (size_t)r * 1024 + col, v[q][i] * lg[i] + lb[i]); } } }
        }
    }
}

extern "C" void kernel_launch(void* const* d_in, const int* in_sizes, int n_in, void* d_out, int out_size, void* d_ws, size_t ws_size, hipStream_t stream) {
    static int grid_blocks = 0;
    if (!grid_blocks) {
        int dev = 0, cus = 0, per_cu = 0;
        hipGetDevice(&dev);
        hipDeviceGetAttribute(&cus, hipDeviceAttributeMultiprocessorCount, dev);
        hipFuncSetAttribute((const void*)mega, hipFuncAttributeMaxDynamicSharedMemorySize, LDS_BYTES);
        hipOccupancyMaxActiveBlocksPerMultiprocessor(&per_cu, (const void*)mega, 512, LDS_BYTES);
        if (per_cu < 1) { fprintf(stderr, "kernel_launch: occupancy query says %d blocks/CU\n", per_cu); per_cu = 1; }
        if (per_cu > 1) per_cu = 1;
        grid_blocks = cus * per_cu;
        if (ws_size < W_END) fprintf(stderr, "kernel_launch: workspace too small: %zu < %zu\n", ws_size, (size_t)W_END);
    }
    hipMemsetAsync((unsigned char*)d_ws + W_BAR, 0, 16384, stream);
    Params p{};
    for (int i = 0; i < 29; ++i) p.in[i] = (const float*)d_in[i];
    p.out = (float*)d_out; p.ws = (unsigned char*)d_ws;
#if MK_LAUNCHES == 1
    p.ph_lo = 0; p.ph_hi = NPHASE;
    void* args[] = {&p};
    hipError_t e = hipLaunchCooperativeKernel((const void*)mega, dim3(grid_blocks), dim3(512), args, LDS_BYTES, stream);
    if (e != hipSuccess) fprintf(stderr, "cooperative launch failed: %s (grid %d)\n", hipGetErrorString(e), grid_blocks);
#else
    for (int ph = 0; ph < NPHASE; ++ph) { p.ph_lo = ph; p.ph_hi = ph + 1;
        for (int rep = 0; rep <= ((HOSTREP >> ph) & 1); ++rep) hipLaunchKernelGGL(mega, dim3(grid_blocks), dim3(512), LDS_BYTES, stream, p); }
#endif
}
```

```cpp
#include <hip/hip_runtime.h>
#include <hip/hip_cooperative_groups.h>
#include <cstdio>
#include <cstdint>
namespace cg = cooperative_groups;

#ifndef HOSTREP
#define HOSTREP 0
#endif
#ifndef MK_LAUNCHES
#define MK_LAUNCHES 1
#endif

#define LAS __attribute__((address_space(3)))
typedef unsigned short bf16_t;
typedef short bf16x8 __attribute__((ext_vector_type(8)));
typedef float f32x4 __attribute__((ext_vector_type(4)));
typedef unsigned u32x4 __attribute__((ext_vector_type(4)));
typedef unsigned u32x2 __attribute__((ext_vector_type(2)));
typedef float f32x2 __attribute__((ext_vector_type(2)));

constexpr int DM = 1024, NB = 16, SEQ = 2048, DB = 32, DS = 64;
constexpr int MP = NB * SEQ, MS = DB * DS, MT = MP + MS;
constexpr int NG = 32, DFF = 2816, KSL = 576;
constexpr int UK = 1152;
constexpr float ALPHA = 1.189207115002721f;
constexpr float LOG2E = 1.4426950408889634f;
constexpr int NPHASE = 12;

constexpr size_t O_Y = 0, O_KP = 35651584, O_VP = 39845888, O_SRP = 44040192, O_SIP = 44072960,
                 O_KS = 44105728, O_VS = 45154304, O_SRS = 46202880, O_SIS = 46268416;

constexpr size_t W_MOD = 0;
constexpr size_t W_WIN = W_MOD + 1179648;
constexpr size_t W_WAP = W_WIN + 8388608;
constexpr size_t W_WGLU = W_WAP + 1048576;
constexpr size_t W_WOUT = W_WGLU + 2097152;
constexpr size_t W_WFI = W_WOUT + 2097152;
constexpr size_t W_WFO = W_WFI + 11534336;
constexpr size_t W_KTAB = W_WFO + 5767168;
constexpr size_t W_ABT = W_KTAB + 2097152;
constexpr size_t W_WE = W_ABT + 16384;
constexpr size_t W_R1 = W_WE + 8388608;
constexpr size_t W_WY = W_R1;
constexpr size_t W_UG = W_WY + 75497472;
constexpr size_t W_EBUF = W_UG + 56623104;
constexpr size_t W_R2 = W_EBUF + 12582912;
constexpr size_t W_H = W_R2;
constexpr size_t W_R3 = W_H + 71303168;
constexpr size_t W_Q = W_R3;
constexpr size_t W_KP = W_Q + 35651584;
constexpr size_t W_KS = W_KP + 33554432;
constexpr size_t W_VT = W_KS + 18874368;
constexpr size_t W_VTS = W_VT + 33554432;
constexpr size_t W_GY = W_VTS + 18874368;
constexpr size_t W_BAR = W_R3 + 196083712;
constexpr size_t W_END = W_BAR + 16384;
constexpr size_t W_X1 = W_R1;
constexpr size_t W_MIX = W_WY;
constexpr size_t W_OATT = W_H;
constexpr size_t W_P1 = W_Q;
constexpr size_t W_ACT = W_R3;
static_assert(W_GY + 35651584 <= W_END, "R3");
static_assert(W_X1 + 142606336 <= W_R2, "X1");

constexpr int LDS_BYTES = 131072 + 1024;

struct Params { const float* in[29]; float* out; unsigned char* ws; int ph_lo, ph_hi; };

__device__ __forceinline__ unsigned cvt_pk_bf16(float lo, float hi) { unsigned r; asm volatile("v_cvt_pk_bf16_f32 %0, %1, %2" : "=v"(r) : "v"(lo), "v"(hi)); return r; }
__device__ __forceinline__ float bf_lo(unsigned u) { return __builtin_bit_cast(float, u << 16); }
__device__ __forceinline__ float bf_hi(unsigned u) { return __builtin_bit_cast(float, u & 0xffff0000u); }
__device__ __forceinline__ float sigmoidf_(float x) { return __builtin_amdgcn_rcpf(1.0f + __builtin_amdgcn_exp2f(-x * LOG2E)); }
__device__ __forceinline__ float sig2_(float x, float y) { return __builtin_amdgcn_rcpf((1.0f + __builtin_amdgcn_exp2f(-x * LOG2E)) * (1.0f + __builtin_amdgcn_exp2f(-y * LOG2E))); }
__device__ __forceinline__ float gelu_tanh(float x) { const float z = 1.5957691216057308f * (x + 0.044715f * x * x * x); return x * sigmoidf_(z); }
__device__ __forceinline__ float wave_sum(float v) {
#pragma unroll
    for (int o = 32; o >= 1; o >>= 1) v += __shfl_xor(v, o);
    return v;
}
__device__ __forceinline__ u32x4 pack8(const f32x4 a, const f32x4 b) { u32x4 r; r[0] = cvt_pk_bf16(a[0], a[1]); r[1] = cvt_pk_bf16(a[2], a[3]); r[2] = cvt_pk_bf16(b[0], b[1]); r[3] = cvt_pk_bf16(b[2], b[3]); return r; }
__device__ __forceinline__ void unpack8(const u32x4 u, f32x4& a, f32x4& b) { a[0] = bf_lo(u[0]); a[1] = bf_hi(u[0]); a[2] = bf_lo(u[1]); a[3] = bf_hi(u[1]); b[0] = bf_lo(u[2]); b[1] = bf_hi(u[2]); b[2] = bf_lo(u[3]); b[3] = bf_hi(u[3]); }
#ifndef NT_STORES
#define NT_STORES 0
#endif
__device__ __forceinline__ void st16(void* p, const u32x4 v) { if (NT_STORES) __builtin_nontemporal_store(v, (u32x4*)p); else *(u32x4*)p = v; }
__device__ __forceinline__ unsigned sigq4(const f32x4 v) {
    unsigned r = 0;
#pragma unroll
    for (int e = 0; e < 4; ++e) { const float sg = sigmoidf_(v[e]); const unsigned q = (unsigned)(sg * 255.0f + 0.5f); r |= (q > 255u ? 255u : q) << (8 * e); }
    return r;
}
__device__ __forceinline__ f32x4 deq4(unsigned u) { f32x4 r; r[0] = (float)(u & 0xffu); r[1] = (float)((u >> 8) & 0xffu); r[2] = (float)((u >> 16) & 0xffu); r[3] = (float)(u >> 24); return r * (1.0f / 255.0f); }
__device__ __forceinline__ f32x4 ldnt4(const float* p) { return __builtin_nontemporal_load((const f32x4*)p); }
__device__ __forceinline__ u32x2 ldnt2(const void* p) { return __builtin_nontemporal_load((const u32x2*)p); }
__device__ __forceinline__ void stnt4(float* p, const f32x4 v) { __builtin_nontemporal_store(v, (f32x4*)p); }
__device__ __forceinline__ int modrow_of(int r) { return r < MP ? (r >> 11) : 16 + ((r - MP) >> 6); }

#ifndef PG8_SP2
#define PG8_SP2 true
#endif
#ifndef PG8_ALIGN
#define PG8_ALIGN true
#endif
namespace pg8 {
constexpr int BM = 256, BK = 64, HALF = 128, HTB = HALF * BK * 2, NXCD = 8, WGM = 4;
__device__ __forceinline__ int lds_byte(int r, int c) { const int st = (r >> 4) * 2 + (c >> 5), rr = r & 15, cc = c & 31, ob = rr * 64 + cc * 2; return st * 1024 + (ob ^ (((ob >> 9) & 1) << 5)); }
__device__ __forceinline__ void stage_rc(int b, int& R, int& C) { const int st = b / 1024, sb = b % 1024, swz = sb ^ (((sb >> 9) & 1) << 5); R = (st >> 1) * 16 + swz / 64; C = (st & 1) * 32 + (swz % 64) / 2; }
__device__ __forceinline__ int perm32(int rho) { const int n = rho >> 4, i = rho & 15; return 8 * (i >> 2) + 4 * n + (i & 3); }

struct Unit { int ra, rb, a, b, kt, k0, part, half; };

struct TileSched {
    int nM, nN, nwg, G, c, kt;
    __device__ void init(int M, int N, int K, int G_, int c_) { nM = M / BM; nN = N / BM; nwg = nM * nN; G = G_; c = c_; kt = K / BK; }
    __device__ bool next(int i, Unit& u) const {
        const long L = (long)i * G + c; if (L >= nwg) return false;
        int wgid = (int)L; { const int q = nwg / NXCD, r = nwg % NXCD, xcd = wgid % NXCD, off = wgid / NXCD; wgid = (xcd < r ? xcd * (q + 1) : r * (q + 1) + (xcd - r) * q) + off; }
        const int nig = WGM * nN, gid = wgid / nig, fm = gid * WGM, gsz = (nM - fm) < WGM ? (nM - fm) : WGM;
        u.a = fm + ((wgid % nig) % gsz); u.b = (wgid % nig) / gsz; u.ra = u.a * BM; u.rb = u.b * BM; u.kt = kt; u.k0 = 0; u.part = 0; u.half = 0; return true;
    }
};
struct ESched {
    int G, c;
    __device__ bool next(int i, Unit& u) const { const int L = i * G + c; if (L >= 96) return false; const int g = L / 3, mt = L % 3; u.ra = g * 768 + mt * 256; u.rb = g * 128; u.a = g; u.b = mt; u.kt = 16; u.k0 = 0; u.part = 0; u.half = (mt == 2); return true; }
};
struct YSched {
    int G, c;
    __device__ bool next(int i, Unit& u) const { const int L = i * G + c; if (L >= 384) return false; const int ntc = 3 - L / 96, idx = L % 96, g = idx / 3, mt = idx % 3;
        u.ra = g * 768 + mt * 256; u.rb = g * 1024 + ntc * 256; u.a = g; u.b = mt * 4 + ntc; u.kt = 6 + 4 * ntc; u.k0 = 0; u.part = 0; u.half = (mt == 2); return true; }
};
struct APSched {
    int G, c;
    __device__ bool next(int i, Unit& u) const { int id;
        if (G == 256) { int lo, n; if (c < 96) { lo = c; n = 1; } else if (c < 128) { lo = 96 + 2 * (c - 96); n = 2; } else if (c < 192) { lo = 160 + 3 * (c - 128); n = 3; } else { lo = 352 + 3 * (c - 192); n = 3; }
            if (i >= n) return false; id = lo + i; }
        else { id = i * G + c; if (id >= 544) return false; }
        u.a = id >> 2; u.b = id & 3; u.ra = u.a * BM; u.rb = u.b * BM; u.kt = 8; u.k0 = 0; u.part = 0; u.half = 0; return true; }
};

struct ResSched {
    int G, c, ktot, S;
    __device__ bool next(int i, Unit& u) const {
        u.half = 0;
        if (G == 256) {
            if (i < 2) { const int id = i * 256 + c; u.a = id >> 2; u.b = id & 3; u.kt = ktot; u.k0 = 0; u.part = 0; u.half = 0; }
            else if (i == 2) { if (c >= 32 * S) return false; const int un = c / S, sl = c % S; u.a = 128 + (un >> 2); u.b = un & 3;
                if (S == 8) { u.k0 = sl < 6 ? 6 * sl : 36 + 4 * (sl - 6); u.kt = sl < 6 ? 6 : 4; } else { u.k0 = 4 * sl; u.kt = 4; }
                u.part = 1 + sl; }
            else return false;
        } else { const int id = i * G + c; if (id >= 544) return false; u.a = id >> 2; u.b = id & 3; u.kt = ktot; u.k0 = 0; u.part = 0; u.half = 0; }
        u.ra = u.a * BM; u.rb = u.b * BM; return true;
    }
};

template <bool ABLK = false, class Epi, class Sched>
__device__ __forceinline__ void gemm_phase(LAS unsigned char* lds, const bf16_t* A, int lda, const bf16_t* Bt, int ldb, const Sched& S, const Epi& E, int ktot = 0) {
    const int tid = threadIdx.x, wid = __builtin_amdgcn_readfirstlane(tid >> 6), lane = tid & 63, wr = wid >> 2, wc = wid & 3, fr = lane & 15, fq = lane >> 4;
    unsigned voffA[2], voffB[2];
#pragma unroll
    for (int i = 0; i < 2; ++i) { int R, C; stage_rc(tid * 16 + i * 8192, R, C); const int Rb = (R & ~31) + perm32(R & 31);
        voffA[i] = (unsigned)(R * (ABLK ? 64 : lda) + C) * 2u; voffB[i] = (unsigned)(Rb * ldb + C) * 2u; }
    const size_t kstepB = (size_t)(BK * 2), kstepA = ABLK ? (size_t)32768 : kstepB;
    const size_t hstepA = ABLK ? (size_t)16384 : (size_t)HALF * lda * 2, hstepB = (size_t)HALF * ldb * 2;
    const size_t ustepA = ABLK ? (size_t)ktot * 32768 / 256 : (size_t)lda * 2;
    const unsigned ldsw = (unsigned)wid * 1024u;
    const int aoff = lds_byte(wr * 64 + fr, fq * 8), boff = lds_byte(wc * 32 + fr, fq * 8);
#define PG8_SA(b, h) (((b) * 2 + (h)) * HTB)
#define PG8_SB(b, h) ((4 + (b) * 2 + (h)) * HTB)
#define PG8_STAGE(bufoff, gbase, voff) do { _Pragma("unroll") for (int _i = 0; _i < 2; ++_i) \
        __builtin_amdgcn_global_load_lds((const unsigned*)((const char*)(gbase) + (voff)[_i]), (LAS unsigned*)(lds + (bufoff) + ldsw + _i * 8192), 16, 0, 0); } while (0)
#define PG8_LDA(dst, b, h) do { _Pragma("unroll") for (int m = 0; m < 4; ++m) _Pragma("unroll") for (int k = 0; k < 2; ++k) dst[m][k] = *(const LAS bf16x8*)(lds + PG8_SA(b, h) + aoff + m * 2048 + k * 1024); } while (0)
#define PG8_LDB(dst, b, h) do { _Pragma("unroll") for (int n = 0; n < 2; ++n) _Pragma("unroll") for (int k = 0; k < 2; ++k) dst[n][k] = *(const LAS bf16x8*)(lds + PG8_SB(b, h) + boff + n * 2048 + k * 1024); } while (0)
#define PG8_MMA(ai, bj, At, Bt_) do { __builtin_amdgcn_s_setprio(1); _Pragma("unroll") for (int m = 0; m < 4; ++m) _Pragma("unroll") for (int n = 0; n < 2; ++n) _Pragma("unroll") for (int k = 0; k < 2; ++k) \
        acc[ai][bj][m][n] = __builtin_amdgcn_mfma_f32_16x16x32_bf16(Bt_[n][k], At[m][k], acc[ai][bj][m][n], 0, 0, 0); __builtin_amdgcn_s_setprio(0); } while (0)
#define PG8_WAIT_V(n) asm volatile("s_waitcnt vmcnt(" #n ")" ::: "memory")
#define PG8_WAIT_L(n) asm volatile("s_waitcnt lgkmcnt(" #n ")" ::: "memory")
#define PG8_BAR __builtin_amdgcn_s_barrier()
#define PG8_SCHED __builtin_amdgcn_sched_barrier(0)
    Unit cur, nxt; int ui = 0;
    if (!S.next(0, cur)) return;
    f32x4 acc[2][2][4][2];
#pragma unroll
    for (int a = 0; a < 2; ++a)
#pragma unroll
        for (int b = 0; b < 2; ++b)
#pragma unroll
            for (int m = 0; m < 4; ++m)
#pragma unroll
                for (int n = 0; n < 2; ++n) acc[a][b][m][n] = (f32x4){0.f, 0.f, 0.f, 0.f};
    bf16x8 At[4][2], B0[2][2], B1[2][2];
    const char* cA = (const char*)A + (size_t)cur.ra * ustepA + (size_t)cur.k0 * kstepA; const char* cB = (const char*)Bt + (size_t)cur.rb * ldb * 2 + (size_t)cur.k0 * kstepB;
    if constexpr (PG8_SP2) {
        PG8_STAGE(PG8_SB(0, 0), cB, voffB); PG8_STAGE(PG8_SB(0, 1), cB + hstepB, voffB); PG8_STAGE(PG8_SA(0, 0), cA, voffA); PG8_STAGE(PG8_SA(0, 1), cA + hstepA, voffA);
        if (wr == 1) PG8_BAR;
        PG8_WAIT_V(2); PG8_BAR;
        PG8_STAGE(PG8_SB(1, 0), cB + kstepB, voffB); PG8_STAGE(PG8_SA(1, 0), cA + kstepA, voffA); PG8_STAGE(PG8_SB(1, 1), cB + hstepB + kstepB, voffB);
        PG8_WAIT_V(6); PG8_BAR;
    } else {
        PG8_STAGE(PG8_SB(0, 0), cB, voffB); PG8_STAGE(PG8_SA(0, 0), cA, voffA); PG8_STAGE(PG8_SB(0, 1), cB + hstepB, voffB); PG8_STAGE(PG8_SA(0, 1), cA + hstepA, voffA);
        if (wr == 1) PG8_BAR;
        PG8_WAIT_V(4); PG8_BAR;
        PG8_STAGE(PG8_SB(1, 0), cB + kstepB, voffB); PG8_STAGE(PG8_SA(1, 0), cA + kstepA, voffA); PG8_STAGE(PG8_SB(1, 1), cB + hstepB + kstepB, voffB);
        PG8_WAIT_V(6); PG8_BAR;
    }
    for (;;) {
        const bool has_next = S.next(ui + 1, nxt);
        const char* nA = has_next ? (const char*)A + (size_t)nxt.ra * ustepA + (size_t)nxt.k0 * kstepA : cA; const char* nB = has_next ? (const char*)Bt + (size_t)nxt.rb * ldb * 2 + (size_t)nxt.k0 * kstepB : cB;
        const int nt = cur.kt; const bool hf = cur.half != 0;
        for (int t = 0; t < nt; t += 2) {
            const bool last = (t == nt - 2);
            const char* a1 = cA + (size_t)(t + 1) * kstepA;
            const char* a2 = last ? nA : cA + (size_t)(t + 2) * kstepA; const char* b2 = last ? nB : cB + (size_t)(t + 2) * kstepB;
            const char* a3 = a2 + kstepA; const char* b3 = b2 + kstepB;
            if constexpr (PG8_SP2) {
            PG8_LDB(B0, 0, 0); PG8_LDB(B1, 0, 1); PG8_SCHED; PG8_LDA(At, 0, 0); PG8_STAGE(PG8_SA(1, 1), a1 + hstepA, voffA);
            PG8_WAIT_V(8); PG8_WAIT_L(0); PG8_BAR; PG8_MMA(0, 0, At, B0); PG8_MMA(0, 1, At, B1); PG8_BAR; PG8_SCHED;
            PG8_LDA(At, 0, 1); PG8_STAGE(PG8_SB(0, 0), b2, voffB); PG8_STAGE(PG8_SB(0, 1), b2 + hstepB, voffB); PG8_STAGE(PG8_SA(0, 0), a2, voffA);
            PG8_WAIT_V(8); PG8_WAIT_L(0); PG8_BAR; if (!hf) { PG8_MMA(1, 0, At, B0); PG8_MMA(1, 1, At, B1); } PG8_BAR; PG8_SCHED;
            PG8_LDB(B0, 1, 0); PG8_LDB(B1, 1, 1); PG8_SCHED; PG8_LDA(At, 1, 0); PG8_STAGE(PG8_SA(0, 1), a2 + hstepA, voffA);
            PG8_WAIT_V(8); PG8_WAIT_L(0); PG8_BAR; PG8_MMA(0, 0, At, B0); PG8_MMA(0, 1, At, B1); PG8_BAR; PG8_SCHED;
            PG8_LDA(At, 1, 1); PG8_STAGE(PG8_SB(1, 0), b3, voffB); PG8_STAGE(PG8_SB(1, 1), b3 + hstepB, voffB); PG8_STAGE(PG8_SA(1, 0), a3, voffA);
            PG8_WAIT_V(8); PG8_WAIT_L(0); PG8_BAR; if (!hf) { PG8_MMA(1, 0, At, B0); PG8_MMA(1, 1, At, B1); } PG8_BAR; PG8_SCHED;
            } else {
            PG8_LDB(B0, 0, 0); PG8_SCHED; PG8_LDA(At, 0, 0); PG8_STAGE(PG8_SA(1, 1), a1 + hstepA, voffA);
            PG8_WAIT_L(8); PG8_BAR; PG8_WAIT_L(0); PG8_MMA(0, 0, At, B0); PG8_BAR; PG8_SCHED;
            PG8_LDB(B1, 0, 1); PG8_STAGE(PG8_SB(0, 0), b2, voffB);
            PG8_BAR; PG8_WAIT_L(0); PG8_MMA(0, 1, At, B1); PG8_BAR;
            PG8_LDA(At, 0, 1); PG8_STAGE(PG8_SA(0, 0), a2, voffA);
            PG8_BAR; PG8_WAIT_L(0); PG8_MMA(1, 0, At, B0); PG8_BAR; PG8_SCHED;
            PG8_STAGE(PG8_SB(0, 1), b2 + hstepB, voffB);
            PG8_WAIT_V(6); PG8_BAR; PG8_MMA(1, 1, At, B1); PG8_BAR;
            PG8_LDB(B0, 1, 0); PG8_SCHED; PG8_LDA(At, 1, 0); PG8_STAGE(PG8_SA(0, 1), a2 + hstepA, voffA);
            PG8_WAIT_L(8); PG8_BAR; PG8_WAIT_L(0); PG8_MMA(0, 0, At, B0); PG8_BAR; PG8_SCHED;
            PG8_LDB(B1, 1, 1); PG8_STAGE(PG8_SB(1, 0), b3, voffB);
            PG8_BAR; PG8_WAIT_L(0); PG8_MMA(0, 1, At, B1); PG8_BAR;
            PG8_LDA(At, 1, 1); PG8_STAGE(PG8_SA(1, 0), a3, voffA);
            PG8_BAR; PG8_WAIT_L(0); PG8_MMA(1, 0, At, B0); PG8_BAR; PG8_SCHED;
            PG8_STAGE(PG8_SB(1, 1), b3 + hstepB, voffB);
            PG8_WAIT_V(6); PG8_BAR; PG8_MMA(1, 1, At, B1); PG8_BAR;
            }
        }
        if constexpr (PG8_ALIGN) { if (wr == 0) PG8_BAR; }
        { int fr2 = fr, fq2 = fq; asm volatile("" : "+v"(fr2), "+v"(fq2)); E(acc, cur, wr, wc, fr2, fq2); }
        if (!has_next) break;
#pragma unroll
        for (int a = 0; a < 2; ++a)
#pragma unroll
            for (int b = 0; b < 2; ++b)
#pragma unroll
                for (int m = 0; m < 4; ++m)
#pragma unroll
                    for (int n = 0; n < 2; ++n) acc[a][b][m][n] = (f32x4){0.f, 0.f, 0.f, 0.f};
        cur = nxt; cA = nA; cB = nB; ++ui;
        if constexpr (PG8_ALIGN) { if (wr == 1) PG8_BAR; }
    }
    PG8_WAIT_V(0);
    if constexpr (!PG8_ALIGN) { if (wr == 0) PG8_BAR; }
    PG8_BAR;
#undef PG8_SA
#undef PG8_SB
#undef PG8_STAGE
#undef PG8_LDA
#undef PG8_LDB
#undef PG8_MMA
#undef PG8_WAIT_V
#undef PG8_WAIT_L
#undef PG8_BAR
#undef PG8_SCHED
}
}
using pg8::Unit;
typedef f32x4 Acc[2][2][4][2];

#define EPI_ROWS_BEGIN _Pragma("unroll") for (int ai = 0; ai < 2; ++ai) _Pragma("unroll") for (int m = 0; m < 4; ++m) { const int rl = 128 * ai + 64 * wr + 16 * m + fr;
#define EPI_ROWS_END }

struct EpiIn {
    bf16_t *Q, *KP, *KS, *VT, *VTS, *UG; unsigned char *GA, *GB; float* out;
    __device__ __forceinline__ void operator()(const Acc& acc, const Unit& u, int wr, int wc, int fr, int fq) const {
        const int pm = u.a, pn = u.b; const bool prm = pm < 128;
        const int c8 = 32 * wc + 8 * fq;
        if (pn < 2) {
            EPI_ROWS_BEGIN { const size_t r = (size_t)pm * 256 + rl;
#pragma unroll
                for (int bj = 0; bj < 2; ++bj) st16(Q + r * 512 + pn * 256 + 128 * bj + c8, pack8(acc[ai][bj][m][0], acc[ai][bj][m][1])); } EPI_ROWS_END
        } else if (pn < 4) {
            EPI_ROWS_BEGIN { const int r = pm * 256 + rl;
#pragma unroll
                for (int bj = 0; bj < 2; ++bj) { const int col = (pn - 2) * 256 + 128 * bj + c8; const u32x4 pk = pack8(acc[ai][bj][m][0], acc[ai][bj][m][1]);
                    if (prm) { const int b = r >> 11, t = r & 2047; st16(KP + (size_t)r * 512 + col, pk);
                        if (t >= 1536) { float* o = out + O_KP + ((size_t)(b * 512 + t - 1536)) * 512 + col; stnt4(o, acc[ai][bj][m][0]); stnt4(o + 4, acc[ai][bj][m][1]); } }
                    else { const int rs = r - MP, b = rs >> 6, t = rs & 63; st16(KS + ((size_t)(b * KSL + 512 + t)) * 512 + col, pk);
                        float* o = out + O_KS + (size_t)rs * 512 + col; stnt4(o, acc[ai][bj][m][0]); stnt4(o + 4, acc[ai][bj][m][1]); } } } EPI_ROWS_END
        } else if (pn < 6) {
            EPI_ROWS_BEGIN { const int r = pm * 256 + rl;
#pragma unroll
                for (int bj = 0; bj < 2; ++bj) { const int col = (pn - 4) * 256 + 128 * bj + c8; const u32x4 pk = pack8(acc[ai][bj][m][0], acc[ai][bj][m][1]);
                    if (prm) { const int b = r >> 11, t = r & 2047; st16(VT + (size_t)r * 512 + col, pk);
                        if (t >= 1536) { float* o = out + O_VP + ((size_t)(b * 512 + t - 1536)) * 512 + col; stnt4(o, acc[ai][bj][m][0]); stnt4(o + 4, acc[ai][bj][m][1]); } }
                    else { const int rs = r - MP, b = rs >> 6, t = rs & 63; st16(VTS + ((size_t)(b * KSL + 512 + t)) * 512 + col, pk);
                        float* o = out + O_VS + (size_t)rs * 512 + col; stnt4(o, acc[ai][bj][m][0]); stnt4(o + 4, acc[ai][bj][m][1]); } } } EPI_ROWS_END
        } else if (pn < 8) {
            EPI_ROWS_BEGIN { const int r = pm * 256 + rl; int row, j;
                if (prm) { const int b = r >> 11, t = r & 2047; row = b * 32 + (t >> 6); j = t & 63; } else { const int rs = r - MP; row = 512 + (rs >> 6); j = rs & 63; }
#pragma unroll
                for (int bj = 0; bj < 2; ++bj) { const int uc = (pn - 6) * 256 + 128 * bj + c8; const int g = uc >> 4, m0 = uc & 15;
                    st16(UG + ((size_t)(g * 768 + row)) * UK + 128 + j * 16 + m0, pack8(acc[ai][bj][m][0], acc[ai][bj][m][1])); } } EPI_ROWS_END
        } else {
            unsigned char* dst = pn < 12 ? GA : GB; const int cb = (pn < 12 ? pn - 8 : pn - 12) * 256;
            EPI_ROWS_BEGIN { const size_t r = (size_t)pm * 256 + rl;
#pragma unroll
                for (int bj = 0; bj < 2; ++bj) { u32x2 q; q[0] = sigq4(acc[ai][bj][m][0]); q[1] = sigq4(acc[ai][bj][m][1]); *(u32x2*)(dst + r * 1024 + cb + 128 * bj + c8) = q; } } EPI_ROWS_END
        }
    }
};

struct EpiE {
    float* EB;
    __device__ __forceinline__ void operator()(const Acc& acc, const Unit& u, int wr, int wc, int fr, int fq) const {
        const int c8 = 32 * wc + 8 * fq;
        EPI_ROWS_BEGIN { float* o = EB + ((size_t)(u.ra + rl)) * 128 + c8; *(f32x4*)o = acc[ai][0][m][0]; *(f32x4*)(o + 4) = acc[ai][0][m][1]; } EPI_ROWS_END
    }
};

struct EpiY {
    bf16_t* GY;
    __device__ __forceinline__ void operator()(const Acc& acc, const Unit& u, int wr, int wc, int fr, int fq) const {
        const int g = u.a, mt = u.b >> 2, ntc = u.b & 3; const int c8 = 32 * wc + 8 * fq;
        EPI_ROWS_BEGIN { int tok0; bool ok = true;
            if (mt < 2) { const int rg = mt * 256 + rl; tok0 = (rg >> 5) * 2048 + (rg & 31) * 64; } else { ok = rl < 32; tok0 = MP + rl * 64; }
            if (ok) {
#pragma unroll
                for (int bj = 0; bj < 2; ++bj) { const int col = ntc * 256 + 128 * bj + c8; const int i = col >> 4, m0 = col & 15;
                    f32x4 a = acc[ai][bj][m][0], b = acc[ai][bj][m][1];
#pragma unroll
                    for (int e = 0; e < 4; ++e) { a[e] = gelu_tanh(a[e]); b[e] = gelu_tanh(b[e]); }
                    st16(GY + ((size_t)(tok0 + i)) * 512 + g * 16 + m0, pack8(a, b)); } } } EPI_ROWS_END
    }
};

struct EpiAP {
    const unsigned char* GA; bf16_t* P1;
    __device__ __forceinline__ void operator()(const Acc& acc, const Unit& u, int wr, int wc, int fr, int fq) const {
        const int c8 = 32 * wc + 8 * fq;
        u32x2 gv[2][4][2];
#pragma unroll
        for (int ai = 0; ai < 2; ++ai) { const size_t base = ((size_t)u.a * 256 + 128 * ai + 64 * wr + fr) * 1024 + u.b * 256 + c8;
#pragma unroll
            for (int m = 0; m < 4; ++m)
#pragma unroll
                for (int bj = 0; bj < 2; ++bj) gv[ai][m][bj] = *(const u32x2*)(GA + base + (size_t)m * 16384 + 128 * bj); }
#pragma unroll
        for (int ai = 0; ai < 2; ++ai)
#pragma unroll
            for (int m = 0; m < 4; ++m)
#pragma unroll
                for (int bj = 0; bj < 2; ++bj) { const f32x4 a = acc[ai][bj][m][0] * deq4(gv[ai][m][bj][0]), b = acc[ai][bj][m][1] * deq4(gv[ai][m][bj][1]);
                    const int col = u.b * 256 + c8 + 128 * bj; st16(P1 + (((size_t)u.a * 16 + (col >> 6)) * 256 + 128 * ai + 64 * wr + fr + 16 * m) * 64 + (col & 63), pack8(a, b)); }
    }
};

struct EpiGLU {
    const unsigned char* GB; const bf16_t* P1; bf16_t* MIX;
    __device__ __forceinline__ void operator()(const Acc& acc, const Unit& u, int wr, int wc, int fr, int fq) const {
        const int c8 = 32 * wc + 8 * fq; const int colg = u.b * 128 + c8;
        u32x2 gv[2][4]; u32x4 pv[2][4];
#pragma unroll
        for (int ai = 0; ai < 2; ++ai) { const size_t base = ((size_t)u.a * 256 + 128 * ai + 64 * wr + fr) * 1024 + colg;
            const size_t bbase = (((size_t)u.a * 16 + (colg >> 6)) * 256 + 128 * ai + 64 * wr + fr) * 64 + (colg & 63);
#pragma unroll
            for (int m = 0; m < 4; ++m) { gv[ai][m] = *(const u32x2*)(GB + base + (size_t)m * 16384); pv[ai][m] = *(const u32x4*)(P1 + bbase + (size_t)m * 1024); } }
#pragma unroll
        for (int ai = 0; ai < 2; ++ai) { const size_t bbase = (((size_t)u.a * 16 + (colg >> 6)) * 256 + 128 * ai + 64 * wr + fr) * 64 + (colg & 63);
#pragma unroll
            for (int m = 0; m < 4; ++m) { f32x4 p0, p1; unpack8(pv[ai][m], p0, p1); const f32x4 g0 = deq4(gv[ai][m][0]), g1 = deq4(gv[ai][m][1]);
                f32x4 a0 = acc[ai][0][m][0], a1 = acc[ai][0][m][1]; const f32x4 b0 = acc[ai][1][m][0], b1 = acc[ai][1][m][1];
#pragma unroll
                for (int e = 0; e < 4; ++e) { a0[e] = p0[e] + a0[e] * g0[e] * sigmoidf_(b0[e]); a1[e] = p1[e] + a1[e] * g1[e] * sigmoidf_(b1[e]); }
                st16(MIX + bbase + (size_t)m * 1024, pack8(a0, a1)); } }
    }
};

__device__ __forceinline__ void atomic_add4(float* p, const f32x4 v) {
#pragma unroll
    for (int e = 0; e < 4; ++e) (void)__hip_atomic_fetch_add(p + e, v[e], __ATOMIC_RELAXED, __HIP_MEMORY_SCOPE_AGENT);
}
template <bool RES_BF16> struct EpiRes {
    const float *xp, *xs; const bf16_t* xb; const float* mod; bf16_t* Tb; float* Ts; int gate_off;
    __device__ __forceinline__ void put(int r, int col, const f32x4 o0, const f32x4 o1, int part) const {
        if (r < MP) st16(Tb + (size_t)r * 1024 + col, pack8(o0, o1));
        else { float* o = Ts + (size_t)(part ? part - 1 : 0) * (2048 * 1024) + (size_t)(r - MP) * 1024 + col; *(f32x4*)o = o0; *(f32x4*)(o + 4) = o1; }
    }
    __device__ __forceinline__ void operator()(const Acc& acc, const Unit& u, int wr, int wc, int fr, int fq) const {
        const int c8 = 32 * wc + 8 * fq; const int part = u.part; const float al = (part >= 2) ? 0.f : ALPHA;
#pragma unroll
        for (int ai = 0; ai < 2; ++ai) {
            const int r0 = u.a * 256 + 128 * ai + 64 * wr + fr;
            const float* gp = mod + (size_t)modrow_of(r0) * 6144 + gate_off;
            const int col0 = u.b * 256 + c8;
            f32x4 gv[2][2];
#pragma unroll
            for (int bj = 0; bj < 2; ++bj)
#pragma unroll
                for (int n = 0; n < 2; ++n) gv[bj][n] = *(const f32x4*)(gp + col0 + 128 * bj + 4 * n);
            if constexpr (RES_BF16) {
                u32x4 xv[4][2];
#pragma unroll
                for (int m = 0; m < 4; ++m)
#pragma unroll
                    for (int bj = 0; bj < 2; ++bj) xv[m][bj] = *(const u32x4*)(xb + (size_t)(r0 + 16 * m) * 1024 + col0 + 128 * bj);
#pragma unroll
                for (int m = 0; m < 4; ++m)
#pragma unroll
                    for (int bj = 0; bj < 2; ++bj) { f32x4 x0, x1; unpack8(xv[m][bj], x0, x1);
                        put(r0 + 16 * m, col0 + 128 * bj, al * x0 + gv[bj][0] * acc[ai][bj][m][0], al * x1 + gv[bj][1] * acc[ai][bj][m][1], part); }
            } else {
                const float* xr = (r0 < MP) ? xp + (size_t)r0 * 1024 : xs + (size_t)(r0 - MP) * 1024;
#pragma unroll
                for (int mp = 0; mp < 2; ++mp) {
                    f32x4 xv[2][2][2];
#pragma unroll
                    for (int mm = 0; mm < 2; ++mm)
#pragma unroll
                        for (int bj = 0; bj < 2; ++bj)
#pragma unroll
                            for (int n = 0; n < 2; ++n) xv[mm][bj][n] = ldnt4(xr + (size_t)(2 * mp + mm) * 16384 + col0 + 128 * bj + 4 * n);
#pragma unroll
                    for (int mm = 0; mm < 2; ++mm)
#pragma unroll
                        for (int bj = 0; bj < 2; ++bj) { const int m = 2 * mp + mm;
                            put(r0 + 16 * m, col0 + 128 * bj, al * xv[mm][bj][0] + gv[bj][0] * acc[ai][bj][m][0], al * xv[mm][bj][1] + gv[bj][1] * acc[ai][bj][m][1], part); }
                }
            }
        }
    }
};

struct EpiFI {
    bf16_t* ACT;
    __device__ __forceinline__ void operator()(const Acc& acc, const Unit& u, int wr, int wc, int fr, int fq) const {
        const int c8 = 32 * wc + 8 * fq;
        EPI_ROWS_BEGIN { const int col = u.b * 128 + c8; const size_t off = (((size_t)u.a * 44 + (col >> 6)) * 256 + rl) * 64 + (col & 63);
            f32x4 a0 = acc[ai][0][m][0], a1 = acc[ai][0][m][1]; const f32x4 b0 = acc[ai][1][m][0], b1 = acc[ai][1][m][1];
#pragma unroll
            for (int e = 0; e < 4; ++e) { a0[e] = a0[e] * sigmoidf_(a0[e]) * b0[e]; a1[e] = a1[e] * sigmoidf_(a1[e]) * b1[e]; }
            st16(ACT + off, pack8(a0, a1)); } EPI_ROWS_END
    }
};

__device__ __forceinline__ void convert_tile(LAS float* tile, const float* src, int ld_src, bf16_t* dst, int ld_dst, int tk, int tn, int HALFN) {
    const int tid = threadIdx.x, j0 = tn * 256, k0 = tk * 64;
    __syncthreads();
#pragma unroll
    for (int e = 0; e < 8; ++e) { const int idx = tid + 512 * e, kk = idx >> 6, n = (idx & 63) * 4; int sc = j0 + n;
        if (HALFN) sc = (n < 128) ? tn * 128 + n : HALFN + tn * 128 + (n - 128);
        *(LAS f32x4*)(tile + kk * 260 + n) = ldnt4(src + (size_t)(k0 + kk) * ld_src + sc); }
    __syncthreads();
    const int jj = tid >> 1, kh = (tid & 1) * 32;
#pragma unroll
    for (int q = 0; q < 4; ++q) { f32x4 a, b;
#pragma unroll
        for (int e = 0; e < 4; ++e) { a[e] = tile[(kh + q * 8 + e) * 260 + jj]; b[e] = tile[(kh + q * 8 + 4 + e) * 260 + jj]; }
        *(u32x4*)(dst + (size_t)(j0 + jj) * ld_dst + k0 + kh + q * 8) = pack8(a, b); }
}

struct D2 { double s, c; };
__device__ __forceinline__ D2 sincos_turns(double turns) {
    const double f = turns - rint(turns);
    const double q = rint(f * 4.0); const int qi = ((int)q) & 3;
    const double r = (f - q * 0.25) * 6.283185307179586476925;
    const double r2 = r * r;
    double s = -1.0 / 1307674368000.0; s = s * r2 + 1.0 / 6227020800.0; s = s * r2 - 1.0 / 39916800.0; s = s * r2 + 1.0 / 362880.0; s = s * r2 - 1.0 / 5040.0; s = s * r2 + 1.0 / 120.0; s = s * r2 - 1.0 / 6.0; s = s * r2 + 1.0; s *= r;
    double c = 1.0 / 20922789888000.0; c = c * r2 - 1.0 / 87178291200.0; c = c * r2 + 1.0 / 479001600.0; c = c * r2 - 1.0 / 3628800.0; c = c * r2 + 1.0 / 40320.0; c = c * r2 - 1.0 / 720.0; c = c * r2 + 1.0 / 24.0; c = c * r2 - 0.5; c = c * r2 + 1.0;
    D2 o;
    if (qi == 0) { o.s = s; o.c = c; } else if (qi == 1) { o.s = c; o.c = -s; } else if (qi == 2) { o.s = -s; o.c = -c; } else { o.s = -c; o.c = s; }
    return o;
}

__device__ __forceinline__ void mod_item(LAS unsigned char* lds, int cgp, const float* cp, const float* cs, const float* w_ada, const float* b_ada, float* MOD) {
    const int tid = threadIdx.x, lane = tid & 63, wave = tid >> 6;
    LAS float* sc = (LAS float*)lds;
    LAS float* red = (LAS float*)(lds + 49152);
    const int cl = tid & 31, kg = tid >> 5, col = cgp * 32 + cl;
    f32x4 acc[12];
#pragma unroll
    for (int j = 0; j < 12; ++j) acc[j] = (f32x4){0.f, 0.f, 0.f, 0.f};
    for (int kc = 0; kc < 4; ++kc) {
        __syncthreads();
        for (int idx = tid; idx < 48 * 256; idx += 512) { const int bb = idx >> 8, kk = idx & 255; const float c = bb < 16 ? cp[bb * 1024 + kc * 256 + kk] : cs[(bb - 16) * 1024 + kc * 256 + kk]; sc[kk * 48 + bb] = c * sigmoidf_(c); }
        __syncthreads();
        float wv[16];
#pragma unroll
        for (int it = 0; it < 16; ++it) wv[it] = __builtin_nontemporal_load(w_ada + (size_t)(kc * 256 + kg + 16 * it) * 6144 + col);
#pragma unroll
        for (int it = 0; it < 16; ++it) { const int kk = kg + 16 * it;
#pragma unroll
            for (int j = 0; j < 12; ++j) acc[j] += *(const LAS f32x4*)(sc + kk * 48 + 4 * j) * wv[it]; }
    }
#pragma unroll
    for (int j = 0; j < 12; ++j)
#pragma unroll
        for (int e = 0; e < 4; ++e) acc[j][e] += __shfl_xor(acc[j][e], 32);
    __syncthreads();
    if (lane < 32) {
#pragma unroll
        for (int j = 0; j < 12; ++j)
#pragma unroll
            for (int e = 0; e < 4; ++e) red[(wave * 48 + 4 * j + e) * 32 + cl] = acc[j][e];
    }
    __syncthreads();
    for (int o = tid; o < 1536; o += 512) { const int bb = o >> 5, c2 = o & 31; float s = b_ada[cgp * 32 + c2];
#pragma unroll
        for (int w = 0; w < 8; ++w) s += red[(w * 48 + bb) * 32 + c2];
        MOD[(size_t)bb * 6144 + cgp * 32 + c2] = s; }
    __syncthreads();
}

__device__ __forceinline__ void ssm_tables(LAS unsigned char* lds, int g, int sl, const Params& p, float* KTAB, float* ABT, bf16_t* WE, bf16_t* WY) {
    const int tid = threadIdx.x;
    LAS float* PW = (LAS float*)lds;
    LAS float* BB = (LAS float*)(lds + 33280);
    LAS float* CC = (LAS float*)(lds + 33280 + 8192);
    LAS float* FF = (LAS float*)(lds + 33280 + 16384);
    const float* a_re = p.in[12] + g * 64; const float* a_im = p.in[13] + g * 64;
    const double dt = exp((double)p.in[14][g]);
    __syncthreads();
    for (int idx = tid; idx < 64 * 65; idx += 512) { const int pp = idx / 65, d = idx % 65; const double lr = dt * (double)a_re[pp], li = dt * (double)a_im[pp];
        const double mag = exp((double)d * lr); const D2 sc = sincos_turns((double)d * li * 0.15915494309189533577);
        PW[idx * 2] = (float)(mag * sc.c); PW[idx * 2 + 1] = (float)(mag * sc.s); }
    if (tid < 64) { const int pp = tid; const double are = a_re[pp], aim = a_im[pp];
        const double mag = exp(dt * are); const D2 sc = sincos_turns(dt * aim * 0.15915494309189533577);
        const double abr = mag * sc.c, abi = mag * sc.s, den = are * are + aim * aim, nre = abr - 1.0;
        FF[pp * 2] = (float)((nre * are + abi * aim) / den); FF[pp * 2 + 1] = (float)((abi * are - nre * aim) / den); }
    for (int idx = tid; idx < 1024; idx += 512) { CC[idx * 2] = p.in[17][g * 1024 + idx]; CC[idx * 2 + 1] = p.in[18][g * 1024 + idx]; }
    __syncthreads();
    for (int idx = tid; idx < 1024; idx += 512) { const int pp = idx >> 4; const float fre = FF[pp * 2], fim = FF[pp * 2 + 1];
        const float br = p.in[15][g * 1024 + idx], bi = p.in[16][g * 1024 + idx];
        BB[idx * 2] = fre * br - fim * bi; BB[idx * 2 + 1] = fre * bi + fim * br; }
    __syncthreads();
    { const int m = (tid >> 4) & 15, mm = tid & 15, d0 = sl * 8 + (tid >> 8) * 4; float a4[4] = {0.f, 0.f, 0.f, 0.f};
        for (int pp = 0; pp < 64; ++pp) { const f32x2 c = *(const LAS f32x2*)(CC + (m * 64 + pp) * 2), bq = *(const LAS f32x2*)(BB + (pp * 16 + mm) * 2);
            const float cbr = c[0] * bq[0] - c[1] * bq[1], cbi = c[0] * bq[1] + c[1] * bq[0];
#pragma unroll
            for (int q = 0; q < 4; ++q) { const f32x2 pw = *(const LAS f32x2*)(PW + (pp * 65 + d0 + q) * 2); a4[q] += cbr * pw[0] - cbi * pw[1]; } }
#pragma unroll
        for (int q = 0; q < 4; ++q) { const int d = d0 + q; float v = a4[q]; if (d == 0 && m == mm) v += p.in[19][g * 16 + m]; KTAB[(size_t)g * 16384 + d * 256 + m * 16 + mm] = v; } }
    for (int o = tid; o < 128 * 16; o += 512) { const int q = o >> 4, k0 = sl * 128 + (o & 15) * 8, j = k0 >> 4, m0 = k0 & 15, pp = q & 63;
        const float pr = PW[(pp * 65 + 63 - j) * 2], pi = PW[(pp * 65 + 63 - j) * 2 + 1]; f32x4 a, b;
#pragma unroll
        for (int e = 0; e < 8; ++e) { const float br = BB[(pp * 16 + m0 + e) * 2], bi = BB[(pp * 16 + m0 + e) * 2 + 1]; const float v = (q < 64) ? pr * br - pi * bi : pr * bi + pi * br; if (e < 4) a[e] = v; else b[e - 4] = v; }
        *(u32x4*)(WE + ((size_t)(g * 128 + q)) * 1024 + k0) = pack8(a, b); }
    for (int o = tid; o < 128 * 16; o += 512) { const int n = sl * 128 + (o >> 4), k0 = (o & 15) * 8, i = n >> 4, m = n & 15; f32x4 a, b;
#pragma unroll
        for (int e = 0; e < 8; ++e) { const int k = k0 + e, pp = k & 63; const float cr = CC[(m * 64 + pp) * 2], ci = CC[(m * 64 + pp) * 2 + 1], pr = PW[(pp * 65 + i + 1) * 2], pi = PW[(pp * 65 + i + 1) * 2 + 1];
            const float v = (k < 64) ? cr * pr - ci * pi : -(cr * pi + ci * pr); if (e < 4) a[e] = v; else b[e - 4] = v; }
        *(u32x4*)(WY + ((size_t)(g * 1024 + n)) * UK + k0) = pack8(a, b); }
    if (sl == 0 && tid < 64) { ABT[(g * 64 + tid) * 2] = PW[(tid * 65 + 64) * 2]; ABT[(g * 64 + tid) * 2 + 1] = PW[(tid * 65 + 64) * 2 + 1]; }
    __syncthreads();
}

__device__ __forceinline__ void ln_row(f32x4 (&v)[4]) {
    float s = 0.f;
#pragma unroll
    for (int i = 0; i < 4; ++i) s += v[i][0] + v[i][1] + v[i][2] + v[i][3];
    const float mean = wave_sum(s) * (1.0f / 1024.0f);
    float q = 0.f;
#pragma unroll
    for (int i = 0; i < 4; ++i)
#pragma unroll
        for (int e = 0; e < 4; ++e) { v[i][e] -= mean; q += v[i][e] * v[i][e]; }
    const float rstd = rsqrtf(wave_sum(q) * (1.0f / 1024.0f) + 1e-5f);
#pragma unroll
    for (int i = 0; i < 4; ++i) v[i] *= rstd;
}

__device__ __forceinline__ float rows_max(float x) {
    float a = x, b = x;
    asm volatile("v_nop\n\tv_nop\n\tv_permlane16_swap_b32 %0, %1" : "+v"(a), "+v"(b));
    a = fmaxf(a, b); b = a;
    asm volatile("v_nop\n\tv_nop\n\tv_permlane32_swap_b32 %0, %1" : "+v"(a), "+v"(b));
    return fmaxf(a, b);
}
__device__ __forceinline__ float rows_sum(float x) {
    float a = x, b = x;
    asm volatile("v_nop\n\tv_nop\n\tv_permlane16_swap_b32 %0, %1" : "+v"(a), "+v"(b));
    a = a + b; b = a;
    asm volatile("v_nop\n\tv_nop\n\tv_permlane32_swap_b32 %0, %1" : "+v"(a), "+v"(b));
    return a + b;
}

__device__ __forceinline__ void attn_phase(LAS unsigned char* lds, int vb, const float* rel_bias, const bf16_t* Q, const bf16_t* KP, const bf16_t* KS, const bf16_t* VT, const bf16_t* VTS, bf16_t* OATT) {
    const int tid = threadIdx.x, lane = tid & 63, h = __builtin_amdgcn_readfirstlane(tid >> 6), fr = lane & 15, g = lane >> 4;
    LAS float* bias2 = (LAS float*)lds;
    __syncthreads();
    for (int i = tid; i < 8 * 640; i += 512) { const int hh = i / 640, d = i % 640 - 63; const int dc = d < -256 ? -256 : (d > 256 ? 256 : d); bias2[i] = rel_bias[hh * 513 + dc + 256] * LOG2E; }
    __syncthreads();
    const LAS float* bh = bias2 + h * 640 + 63;
    LAS unsigned char* vl = lds + 20480 + h * 4096;
    const float sc = 0.125f * LOG2E;
    const int G = gridDim.x, crev = G - 1 - vb;
    for (int L = crev; L < 544; L += G) {
        int qrow0, nk; const bf16_t* kbase; const bf16_t* vbase;
        if (L < 32) { const int b = L; qrow0 = MP + b * 64; nk = 576; kbase = KS + (size_t)b * KSL * 512 + h * 64; vbase = VTS + (size_t)b * KSL * 512 + h * 64; }
        else { const int L2 = L - 32; int c, b; if (L2 < 384) { b = L2 / 24; c = 8 + L2 % 24; } else { const int L3 = L2 - 384; c = 7 - (L3 >> 4); b = L3 & 15; } qrow0 = b * 2048 + c * 64; nk = (c < 8 ? c + 1 : 9) * 64;
            const int k0 = (c + 1) * 64 - nk; kbase = KP + ((size_t)(b * 2048 + k0)) * 512 + h * 64; vbase = VT + ((size_t)(b * 2048 + k0)) * 512 + h * 64; }
        bf16x8 Qf[4][2];
#pragma unroll
        for (int qb = 0; qb < 4; ++qb)
#pragma unroll
            for (int ks = 0; ks < 2; ++ks) Qf[qb][ks] = *(const bf16x8*)(Q + ((size_t)(qrow0 + qb * 16 + fr)) * 512 + h * 64 + ks * 32 + g * 8);
        f32x4 O[4][4]; float mrow[4], lrow[4];
#pragma unroll
        for (int a = 0; a < 4; ++a) { mrow[a] = -INFINITY; lrow[a] = 0.f;
#pragma unroll
            for (int b = 0; b < 4; ++b) O[a][b] = (f32x4){0.f, 0.f, 0.f, 0.f}; }
        const int ntile = nk >> 5;
        const int krow = 8 * (fr >> 2) + (fr & 3);
        bf16x8 Kf[2][2], Vf[4];
#pragma unroll
        for (int kb = 0; kb < 2; ++kb)
#pragma unroll
            for (int ks = 0; ks < 2; ++ks) Kf[kb][ks] = *(const bf16x8*)(kbase + ((size_t)(krow + 4 * kb)) * 512 + ks * 32 + g * 8);
#pragma unroll
        for (int i = 0; i < 4; ++i) Vf[i] = *(const bf16x8*)(vbase + (size_t)((i * 64 + lane) >> 3) * 512 + (lane & 7) * 8);
        for (int t = 0; t < ntile; ++t) {
            f32x4 S[2][4];
#pragma unroll
            for (int kb = 0; kb < 2; ++kb)
#pragma unroll
                for (int qb = 0; qb < 4; ++qb) { f32x4 s = (f32x4){0.f, 0.f, 0.f, 0.f};
#pragma unroll
                    for (int ks = 0; ks < 2; ++ks) s = __builtin_amdgcn_mfma_f32_16x16x32_bf16(Kf[kb][ks], Qf[qb][ks], s, 0, 0, 0);
                    S[kb][qb] = s; }
            if (t + 1 < ntile) {
#pragma unroll
                for (int kb = 0; kb < 2; ++kb)
#pragma unroll
                    for (int ks = 0; ks < 2; ++ks) Kf[kb][ks] = *(const bf16x8*)(kbase + ((size_t)((t + 1) * 32 + krow + 4 * kb)) * 512 + ks * 32 + g * 8);
            }
            bf16x8 Pf[4];
            float sv[4][2][4], mx[4];
            if (nk - 95 - t * 32 >= 256) {
                const float bc = bh[256];
#pragma unroll
                for (int qb = 0; qb < 4; ++qb) { float m_ = -INFINITY;
#pragma unroll
                    for (int kb = 0; kb < 2; ++kb)
#pragma unroll
                        for (int r = 0; r < 4; ++r) { const float v = S[kb][qb][r] * sc + bc; sv[qb][kb][r] = v; m_ = fmaxf(m_, v); }
                    mx[qb] = m_; }
            } else {
#pragma unroll
            for (int qb = 0; qb < 4; ++qb) {
                const int dbase = qb * 16 + fr + nk - 64 - t * 32 - 8 * g; float m_ = -INFINITY;
#pragma unroll
                for (int kb = 0; kb < 2; ++kb)
#pragma unroll
                    for (int r = 0; r < 4; ++r) { const float v = S[kb][qb][r] * sc + bh[dbase - 4 * kb - r]; sv[qb][kb][r] = v; m_ = fmaxf(m_, v); }
                mx[qb] = m_;
            }
            }
#pragma unroll
            for (int qb = 0; qb < 4; ++qb) mx[qb] = rows_max(mx[qb]);
#pragma unroll
            for (int qb = 0; qb < 4; ++qb) {
                if (__builtin_amdgcn_ballot_w64(mx[qb] - mrow[qb] > 11.0f) != 0ull) {
                    const float mnew = fmaxf(mrow[qb], mx[qb]); const float alpha = __builtin_amdgcn_exp2f(mrow[qb] - mnew); mrow[qb] = mnew; lrow[qb] *= alpha;
#pragma unroll
                    for (int hb = 0; hb < 4; ++hb) O[hb][qb] *= alpha;
                }
                const float mcur = mrow[qb]; float ps = 0.f;
#pragma unroll
                for (int kb = 0; kb < 2; ++kb)
#pragma unroll
                    for (int r = 0; r < 4; ++r) { sv[qb][kb][r] = __builtin_amdgcn_exp2f(sv[qb][kb][r] - mcur); ps += sv[qb][kb][r]; }
                lrow[qb] += ps;
                u32x4 pk; pk[0] = cvt_pk_bf16(sv[qb][0][0], sv[qb][0][1]); pk[1] = cvt_pk_bf16(sv[qb][0][2], sv[qb][0][3]); pk[2] = cvt_pk_bf16(sv[qb][1][0], sv[qb][1][1]); pk[3] = cvt_pk_bf16(sv[qb][1][2], sv[qb][1][3]);
                Pf[qb] = __builtin_bit_cast(bf16x8, pk);
            }
            __builtin_amdgcn_wave_barrier();
#pragma unroll
            for (int i = 0; i < 4; ++i) { const int key = (i * 64 + lane) >> 3; *(LAS bf16x8*)(vl + key * 128 + (((lane & 7) ^ (((key >> 1) & 1) | (((key >> 3) & 1) << 1))) * 16)) = Vf[i]; }
            __builtin_amdgcn_fence(__ATOMIC_RELEASE, "wavefront"); __builtin_amdgcn_wave_barrier();
            bf16x8 Vt[4];
            {
                const int q = (lane >> 2) & 3, pp = lane & 3, r0 = 8 * g + q, r1 = r0 + 4;
                const unsigned f0 = ((r0 >> 1) & 1) | (((r0 >> 3) & 1) << 1), f1 = ((r1 >> 1) & 1) | (((r1 >> 3) & 1) << 1);
                const unsigned vb0 = (unsigned)(size_t)vl + r0 * 128 + 8 * (pp & 1), vb1 = (unsigned)(size_t)vl + r1 * 128 + 8 * (pp & 1);
                u32x2 t0[4], t1[4];
#pragma unroll
                for (int hb = 0; hb < 4; ++hb) { const unsigned ch = (unsigned)(2 * hb + (pp >> 1));
                    asm volatile("ds_read_b64_tr_b16 %0, %1" : "=&v"(t0[hb]) : "v"(vb0 + ((ch ^ f0) << 4)) : "memory");
                    asm volatile("ds_read_b64_tr_b16 %0, %1" : "=&v"(t1[hb]) : "v"(vb1 + ((ch ^ f1) << 4)) : "memory"); }
                asm volatile("s_waitcnt lgkmcnt(0)" : "+v"(t0[0]), "+v"(t0[1]), "+v"(t0[2]), "+v"(t0[3]), "+v"(t1[0]), "+v"(t1[1]), "+v"(t1[2]), "+v"(t1[3]) :: "memory");
#pragma unroll
                for (int hb = 0; hb < 4; ++hb) { u32x4 w; w[0] = t0[hb][0]; w[1] = t0[hb][1]; w[2] = t1[hb][0]; w[3] = t1[hb][1]; Vt[hb] = __builtin_bit_cast(bf16x8, w); }
            }
#pragma unroll
            for (int hb = 0; hb < 4; ++hb)
#pragma unroll
                for (int qb = 0; qb < 4; ++qb) O[hb][qb] = __builtin_amdgcn_mfma_f32_16x16x32_bf16(Vt[hb], Pf[qb], O[hb][qb], 0, 0, 0);
            if (t + 1 < ntile) {
#pragma unroll
                for (int i = 0; i < 4; ++i) Vf[i] = *(const bf16x8*)(vbase + (size_t)((t + 1) * 32 + ((i * 64 + lane) >> 3)) * 512 + (lane & 7) * 8);
            }
        }
#pragma unroll
        for (int qb = 0; qb < 4; ++qb) { const float l = rows_sum(lrow[qb]); const float inv = 1.0f / l;
#pragma unroll
            for (int hb = 0; hb < 4; ++hb) { const f32x4 o = O[hb][qb] * inv; u32x2 pk; pk[0] = cvt_pk_bf16(o[0], o[1]); pk[1] = cvt_pk_bf16(o[2], o[3]);
                *(u32x2*)(OATT + ((size_t)(qrow0 + qb * 16 + fr)) * 512 + h * 64 + hb * 16 + 4 * g) = pk; } }
    }
}

#define XB_TMO      128
#define XB_XCNT(j)  (256  + 64 * (j))
#define XB_XSUB(j)  (1280 + 64 * (j))
#define XB_XGEN(j)  (2304 + 64 * (j))
#define XB_TOP      3328
#define XB_TOPGEN   3392
#define XCD_BAR_WORDS 3456
#define XB_SPIN_CAP (1u << 18)

__device__ __forceinline__ unsigned xb_ld(unsigned* p)              { return __hip_atomic_load(p, __ATOMIC_RELAXED, __HIP_MEMORY_SCOPE_AGENT); }
__device__ __forceinline__ unsigned xb_add(unsigned* p, unsigned v) { return __hip_atomic_fetch_add(p, v, __ATOMIC_RELAXED, __HIP_MEMORY_SCOPE_AGENT); }
__device__ __forceinline__ unsigned xb_xcc_id() { return (unsigned)__builtin_amdgcn_s_getreg((3 << 11) | 20) & 0xFu; }
#define XB_SPIN(cond, bar) do { unsigned _sp = 0; while (cond) { __builtin_amdgcn_s_sleep(1); \
    if ((++_sp & 255u) == 0u) { if (xb_ld(&(bar)[XB_TMO])) break; if (_sp > XB_SPIN_CAP) { atomicAdd(&(bar)[XB_TMO], 1u); break; } } } } while (0)

struct XcdBarrier {
    unsigned* bar; unsigned x;
    volatile LAS unsigned* st;
};

__device__ __forceinline__ XcdBarrier xcd_barrier_post(unsigned* bar, volatile LAS unsigned* st) {
    XcdBarrier b; b.bar = bar; b.x = xb_xcc_id(); b.st = st;
    if (threadIdx.x == 0) st[2] = xb_add(&bar[XB_XCNT(b.x)], 1u);
    return b;
}
__device__ __forceinline__ void xcd_barrier_complete(unsigned* bar, unsigned x, unsigned& nloc, unsigned& nx) {
    const unsigned G = gridDim.x * gridDim.y * gridDim.z;
    unsigned sum, cnt, mine, sp = 0u;
    for (;;) {
        sum = 0u; cnt = 0u; mine = 0u;
#pragma unroll
        for (unsigned j = 0; j < 16; ++j) { const unsigned c = xb_ld(&bar[XB_XCNT(j)]); sum += c; cnt += (c > 0u) ? 1u : 0u; mine = (j == x) ? c : mine; }
        if (sum == G) break;
        __builtin_amdgcn_s_sleep(1);
        if ((++sp & 255u) == 0u) { if (xb_ld(&bar[XB_TMO])) break; if (sp > XB_SPIN_CAP) { atomicAdd(&bar[XB_TMO], 1u); break; } }
    }
    nloc = mine > 0u ? mine : 1u; nx = cnt > 0u ? cnt : 1u;
}

__device__ __forceinline__ void xcd_barrier(const XcdBarrier& b) {
    asm volatile("s_waitcnt vmcnt(0)" ::: "memory");
    __syncthreads();
    if (threadIdx.x == 0) {
        unsigned* bar = b.bar;
        __builtin_amdgcn_s_waitcnt(0);
        unsigned nloc = b.st[0], nx = b.st[1];
        if (nloc == 0u) { xcd_barrier_complete(bar, b.x, nloc, nx); b.st[0] = nloc; b.st[1] = nx; }
        const unsigned old = xb_add(&bar[XB_XSUB(b.x)], 1u);
        const unsigned gen = old / nloc;
        if (old + 1u == (gen + 1u) * nloc) {
            __builtin_amdgcn_fence(__ATOMIC_RELEASE, "agent");
            asm volatile("s_waitcnt vmcnt(0)" ::: "memory");
            const unsigned og = xb_add(&bar[XB_TOP], 1u);
            const unsigned tg = og / nx;
            if (og + 1u == (tg + 1u) * nx) xb_add(&bar[XB_TOPGEN], 1u);
            else XB_SPIN(xb_ld(&bar[XB_TOPGEN]) == tg, bar);
            __builtin_amdgcn_fence(__ATOMIC_ACQUIRE, "agent");
            xb_add(&bar[XB_XGEN(b.x)], 1u);
            asm volatile("s_waitcnt vmcnt(0)" ::: "memory");
        } else {
            XB_SPIN(xb_ld(&bar[XB_XGEN(b.x)]) == gen, bar);
            __builtin_amdgcn_fence(__ATOMIC_ACQUIRE, "agent");
            asm volatile("s_waitcnt vmcnt(0)" ::: "memory");
        }
    }
    __syncthreads();
}


__device__ __forceinline__ int ln_row_of(int k, int w, int np, int ns) { if (k < np) { const int r = w * np + k; return r < MP ? r : -1; } const int r = w * ns + (k - np); return r < MS ? MP + r : -1; }

__global__ void __launch_bounds__(512, 2) mega(Params p) {
    extern __shared__ __attribute__((aligned(16))) unsigned char smem[];
    LAS unsigned char* lds = (LAS unsigned char*)smem;
    const int tid = threadIdx.x, lane = tid & 63, wave = tid >> 6, G = gridDim.x, bid = blockIdx.x;
    unsigned char* ws = p.ws; float* out = p.out;
    float* MOD = (float*)(ws + W_MOD);
    bf16_t* WIN = (bf16_t*)(ws + W_WIN); bf16_t* WAP = (bf16_t*)(ws + W_WAP); bf16_t* WGLU = (bf16_t*)(ws + W_WGLU); bf16_t* WOUT = (bf16_t*)(ws + W_WOUT);
    bf16_t* WFI = (bf16_t*)(ws + W_WFI); bf16_t* WFO = (bf16_t*)(ws + W_WFO);
    float* KTAB = (float*)(ws + W_KTAB); float* ABT = (float*)(ws + W_ABT); bf16_t* WE = (bf16_t*)(ws + W_WE);
    bf16_t* WY = (bf16_t*)(ws + W_WY); bf16_t* UG = (bf16_t*)(ws + W_UG); float* EBUF = (float*)(ws + W_EBUF);
    bf16_t* H = (bf16_t*)(ws + W_H); bf16_t* Qb = (bf16_t*)(ws + W_Q); bf16_t* KP = (bf16_t*)(ws + W_KP); bf16_t* KS = (bf16_t*)(ws + W_KS);
    bf16_t* VT = (bf16_t*)(ws + W_VT); bf16_t* VTS = (bf16_t*)(ws + W_VTS); bf16_t* GY = (bf16_t*)(ws + W_GY);
    bf16_t* X1b = (bf16_t*)(ws + W_X1); float* TS1 = (float*)(ws + W_Q); float* TS2 = (float*)(ws + W_X1 + 71303168); bf16_t* MIX = (bf16_t*)(ws + W_MIX); bf16_t* OATT = (bf16_t*)(ws + W_OATT); bf16_t* P1 = (bf16_t*)(ws + W_P1); bf16_t* ACT = (bf16_t*)(ws + W_ACT);
    unsigned char* GA = (unsigned char*)out; unsigned char* GB = GA + (size_t)MT * 1024;
    cg::grid_group grid = cg::this_grid();
    int vb = (G % 8 == 0) ? (bid % 8) * (G / 8) + bid / 8 : bid;
    int cb = bid;
#ifndef ONLY
#define ONLY -1
#endif
#ifndef REPMASK
#define REPMASK 0
#endif
#define PHASE(k) if ((ONLY < 0 || ONLY == (k)) && p.ph_lo <= (k) && (k) < p.ph_hi) for (int rep_ = 0; rep_ <= ((REPMASK >> (k)) & 1); ++rep_)
#define REPSYNC if (rep_) grid.sync();
    volatile LAS unsigned* bst = (volatile LAS unsigned*)(lds + 131072);
    if (tid < 4) bst[tid] = 0u;
    __syncthreads();
    XcdBarrier xbar = xcd_barrier_post((unsigned*)(ws + W_BAR), bst);
#define SEAM(k) if (p.ph_lo < (k) && (k) < p.ph_hi) { if (p.ph_hi > 1000) grid.sync(); else xcd_barrier(xbar); }

    PHASE(0) { REPSYNC
        for (int w = vb; w < 256; w += G) {
            if (w < 192) mod_item(lds, w, p.in[2], p.in[3], p.in[8], p.in[9], MOD);
            ssm_tables(lds, w >> 3, w & 7, p, KTAB, ABT, WE, WY);
        }
        LAS float* tile = (LAS float*)lds;
        for (int t = vb; t < 944; t += G) {
            if (t < 256) convert_tile(tile, p.in[10], 4096, WIN, 1024, t % 16, t / 16, 0);
            else if (t < 288) { const int q = t - 256; convert_tile(tile, p.in[20], 1024, WAP, 512, q % 8, q / 8, 0); }
            else if (t < 352) { const int q = t - 288; convert_tile(tile, p.in[21], 2048, WGLU, 512, q % 8, q / 8, 1024); }
            else if (t < 416) { const int q = t - 352; convert_tile(tile, p.in[22], 1024, WOUT, 1024, q % 16, q / 16, 0); }
            else if (t < 768) { const int q = t - 416; convert_tile(tile, p.in[25], 5632, WFI, 1024, q % 16, q / 16, 2816); }
            else { const int q = t - 768; convert_tile(tile, p.in[26], 1024, WFO, 2816, q % 44, q / 44, 0); }
        }
        for (size_t idx = (size_t)bid * 512 + tid; idx < (size_t)32 * 512 * 64; idx += (size_t)G * 512) { const size_t row = idx >> 6; const int c8 = (int)(idx & 63) * 8; const int b = (int)(row >> 9), pos = (int)(row & 511);
            const float* s = p.in[4] + row * 512 + c8; const float* s2 = p.in[5] + row * 512 + c8; const f32x4 k0 = ldnt4(s), k1 = ldnt4(s + 4), v0 = ldnt4(s2), v1 = ldnt4(s2 + 4);
            *(u32x4*)(KS + ((size_t)(b * KSL + pos)) * 512 + c8) = pack8(k0, k1); *(u32x4*)(VTS + ((size_t)(b * KSL + pos)) * 512 + c8) = pack8(v0, v1); }
    }
    SEAM(1)
    if (p.ph_lo < 1 && 1 < p.ph_hi && G % 8 == 0) {
        if (tid == 0) { unsigned base = 0; for (unsigned j = 0; j < 16; ++j) { const unsigned cnt = xb_ld((unsigned*)(ws + W_BAR) + XB_XCNT(j)); if (j < xbar.x) base += cnt; } bst[3] = base + bst[2]; }
        __syncthreads();
        vb = (int)bst[3]; cb = (vb % (G / 8)) * 8 + vb / (G / 8);
        __syncthreads();
    }
    PHASE(1) { REPSYNC
        { const int rpw = (MT + G * 8 - 1) / (G * 8); const int rbeg = (bid * 8 + wave) * rpw; const int rend = rbeg + rpw < MT ? rbeg + rpw : MT;
          int cur_mr = -1; f32x4 sh[4], sc[4];
          for (int r0 = rbeg; r0 < rend; r0 += 8) {
            f32x4 v[8][4];
#pragma unroll
            for (int q = 0; q < 8; ++q) { const int r = r0 + q < rend ? r0 + q : rend - 1; const float* xr = (r < MP) ? p.in[0] + (size_t)r * 1024 : p.in[1] + (size_t)(r - MP) * 1024;
#pragma unroll
                for (int i = 0; i < 4; ++i) v[q][i] = ldnt4(xr + i * 256 + lane * 4); }
#pragma unroll
            for (int q = 0; q < 8; ++q) { const int r = r0 + q; if (r < rend) {
                const int mr = modrow_of(r);
                if (mr != cur_mr) { cur_mr = mr; const float* md = MOD + (size_t)mr * 6144;
#pragma unroll
                    for (int i = 0; i < 4; ++i) { sh[i] = *(const f32x4*)(md + i * 256 + lane * 4); sc[i] = *(const f32x4*)(md + 1024 + i * 256 + lane * 4); } }
                ln_row(v[q]);
#pragma unroll
                for (int i = 0; i < 4; ++i) { const int col = i * 256 + lane * 4; const f32x4 hv = v[q][i] * (1.0f + sc[i]) + sh[i];
                    u32x2 pk; pk[0] = cvt_pk_bf16(hv[0], hv[1]); pk[1] = cvt_pk_bf16(hv[2], hv[3]); *(u32x2*)(H + (size_t)r * 1024 + col) = pk; } } }
          } }
    }
    SEAM(2)
    PHASE(2) { REPSYNC
        pg8::TileSched S; S.init(MT, 4096, 1024, G, cb);
        EpiIn E{Qb, KP, KS, VT, VTS, UG, GA, GB, out};
        pg8::gemm_phase(lds, H, 1024, WIN, 1024, S, E);
        const bool half = (G == 256); const int wyn = half ? 128 : G, wyb = half ? cb - 128 : bid;
        if (wyb >= 0) {
        for (size_t idx0 = (size_t)wyb * 512 + tid; idx0 < (size_t)32 * 1024 * 128; idx0 += (size_t)wyn * 512 * 4) {
            f32x4 ka[4], kb[4]; bool nz[4];
#pragma unroll
            for (int q = 0; q < 4; ++q) { const size_t idx = idx0 + (size_t)q * wyn * 512; nz[q] = false;
                if (idx < (size_t)32 * 1024 * 128) { const int g = (int)(idx >> 17), n = (int)(idx >> 7) & 1023, k0 = (int)(idx & 127) * 8; const int j = k0 >> 4, m0 = k0 & 15, i = n >> 4, m = n & 15;
                    if (i >= j) { nz[q] = true; const float* s = KTAB + (size_t)g * 16384 + (i - j) * 256 + m * 16 + m0; ka[q] = *(const f32x4*)s; kb[q] = *(const f32x4*)(s + 4); } } }
#pragma unroll
            for (int q = 0; q < 4; ++q) { const size_t idx = idx0 + (size_t)q * wyn * 512;
                if (idx < (size_t)32 * 1024 * 128) { const int g = (int)(idx >> 17), n = (int)(idx >> 7) & 1023, k0 = (int)(idx & 127) * 8;
                    *(u32x4*)(WY + ((size_t)(g * 1024 + n)) * UK + 128 + k0) = nz[q] ? pack8(ka[q], kb[q]) : (u32x4){0u, 0u, 0u, 0u}; } }
        }
        }
    }
    SEAM(3)
    PHASE(3) { REPSYNC
        { pg8::ESched S{G, vb}; EpiE E{EBUF}; pg8::gemm_phase(lds, UG + 128, UK, WE, 1024, S, E); }
        attn_phase(lds, vb, p.in[11], Qb, KP, KS, VT, VTS, OATT);
    }
    SEAM(4)
    PHASE(4) { REPSYNC
        for (int idx = bid * 512 + tid; idx < 98304; idx += G * 512) {
            const bool prm = idx < 32768; const int i2 = prm ? idx : idx - 32768; const int b = i2 >> 11, g = (i2 >> 6) & 31, pp = i2 & 63;
            const float ar = ABT[(g * 64 + pp) * 2], ai = ABT[(g * 64 + pp) * 2 + 1];
            if (prm) { float sr = 0.f, si = 0.f; float er[32], ei[32];
#pragma unroll
                for (int c = 0; c < 32; ++c) { const size_t row = (size_t)g * 768 + b * 32 + c; er[c] = EBUF[row * 128 + pp]; ei[c] = EBUF[row * 128 + 64 + pp]; }
#pragma unroll
                for (int c = 0; c < 32; ++c) { const size_t row = (size_t)g * 768 + b * 32 + c; UG[row * UK + pp] = (bf16_t)(cvt_pk_bf16(sr, 0.f) & 0xffffu); UG[row * UK + 64 + pp] = (bf16_t)(cvt_pk_bf16(si, 0.f) & 0xffffu);
                    const float nr = ar * sr - ai * si + er[c], ni = ar * si + ai * sr + ei[c]; sr = nr; si = ni; }
                out[O_SRP + (size_t)(b * 32 + g) * 64 + pp] = sr; out[O_SIP + (size_t)(b * 32 + g) * 64 + pp] = si; }
            else { float sr = p.in[6][(size_t)(b * 32 + g) * 64 + pp], si = p.in[7][(size_t)(b * 32 + g) * 64 + pp]; const size_t row = (size_t)g * 768 + 512 + b;
                UG[row * UK + pp] = (bf16_t)(cvt_pk_bf16(sr, 0.f) & 0xffffu); UG[row * UK + 64 + pp] = (bf16_t)(cvt_pk_bf16(si, 0.f) & 0xffffu);
                const float er = EBUF[row * 128 + pp], ei = EBUF[row * 128 + 64 + pp]; const float nr = ar * sr - ai * si + er, ni = ar * si + ai * sr + ei;
                out[O_SRS + (size_t)(b * 32 + g) * 64 + pp] = nr; out[O_SIS + (size_t)(b * 32 + g) * 64 + pp] = ni; }
        }
    }
    SEAM(5)
    PHASE(5) { REPSYNC
        { pg8::YSched S{G, vb}; EpiY E{GY}; pg8::gemm_phase(lds, UG, UK, WY, UK, S, E); }
        { pg8::APSched S{G, vb}; EpiAP E{GA, P1}; pg8::gemm_phase(lds, OATT, 512, WAP, 512, S, E); }
    }
    SEAM(6)
    PHASE(6) { REPSYNC pg8::TileSched S; S.init(MT, 2048, 512, G, cb); EpiGLU E{GB, P1, MIX}; pg8::gemm_phase(lds, GY, 512, WGLU, 512, S, E); }
    SEAM(7)
    PHASE(7) { REPSYNC pg8::ResSched S{G, vb, 16, 4}; EpiRes<false> E{p.in[0], p.in[1], nullptr, MOD, (bf16_t*)out, TS1, 2048}; pg8::gemm_phase<true>(lds, MIX, 64, WOUT, 1024, S, E, 16); }
    SEAM(8)
    PHASE(8) { REPSYNC
        const int NW = G * 8, wg_ = bid * 8 + wave, np_ = (MP + NW - 1) / NW, ns_ = (MS + NW - 1) / NW, ntot = np_ + ns_;
        int cur_mr = -1; f32x4 sh[4], sc[4], lg[4], lb[4];
#pragma unroll
        for (int i = 0; i < 4; ++i) { lg[i] = *(const f32x4*)(p.in[23] + i * 256 + lane * 4); lb[i] = *(const f32x4*)(p.in[24] + i * 256 + lane * 4); }
        for (int k0 = 0; k0 < ntot; k0 += 6) {
            f32x4 v[6][4];
#pragma unroll
            for (int q = 0; q < 6; ++q) { const int rr = (k0 + q < ntot) ? ln_row_of(k0 + q, wg_, np_, ns_) : -1; const int r = rr < 0 ? 0 : rr;
#pragma unroll
                for (int i = 0; i < 4; ++i) { if (r < MP) { const u32x2 t = ldnt2((const bf16_t*)out + (size_t)r * 1024 + i * 256 + lane * 4); v[q][i] = (f32x4){bf_lo(t[0]), bf_hi(t[0]), bf_lo(t[1]), bf_hi(t[1])}; }
                    else { const float* tp = TS1 + (size_t)(r - MP) * 1024 + i * 256 + lane * 4; f32x4 a = *(const f32x4*)tp;
                        if (G == 256) { for (int sl = 1; sl < 4; ++sl) a += *(const f32x4*)(tp + (size_t)sl * 2048 * 1024); } v[q][i] = a; } } }
#pragma unroll
            for (int q = 0; q < 6; ++q) { const int r = (k0 + q < ntot) ? ln_row_of(k0 + q, wg_, np_, ns_) : -1; if (r >= 0) {
                const int mr = modrow_of(r);
                if (mr != cur_mr) { cur_mr = mr; const float* md = MOD + (size_t)mr * 6144;
#pragma unroll
                    for (int i = 0; i < 4; ++i) { sh[i] = *(const f32x4*)(md + 3072 + i * 256 + lane * 4); sc[i] = *(const f32x4*)(md + 4096 + i * 256 + lane * 4); } }
                ln_row(v[q]);
#pragma unroll
                for (int i = 0; i < 4; ++i) { const int col = i * 256 + lane * 4; v[q][i] = v[q][i] * lg[i] + lb[i]; u32x2 pk; pk[0] = cvt_pk_bf16(v[q][i][0], v[q][i][1]); pk[1] = cvt_pk_bf16(v[q][i][2], v[q][i][3]); *(u32x2*)(X1b + (size_t)r * 1024 + col) = pk; }
                ln_row(v[q]);
#pragma unroll
                for (int i = 0; i < 4; ++i) { const int col = i * 256 + lane * 4; const f32x4 hv = v[q][i] * (1.0f + sc[i]) + sh[i];
                    u32x2 pk; pk[0] = cvt_pk_bf16(hv[0], hv[1]); pk[1] = cvt_pk_bf16(hv[2], hv[3]); *(u32x2*)(H + (size_t)r * 1024 + col) = pk; } } }
        }
    }
    SEAM(9)
    PHASE(9) { REPSYNC pg8::TileSched S; S.init(MT, 5632, 1024, G, cb); EpiFI E{ACT}; pg8::gemm_phase(lds, H, 1024, WFI, 1024, S, E); }
    SEAM(10)
    PHASE(10) { REPSYNC pg8::ResSched S{G, vb, 44, 8}; EpiRes<true> E{nullptr, nullptr, X1b, MOD, H, TS2, 5120}; pg8::gemm_phase<true>(lds, ACT, 64, WFO, DFF, S, E, 44); }
    SEAM(11)
    PHASE(11) { REPSYNC
        const int NW = G * 8, wg_ = bid * 8 + wave, np_ = (MP + NW - 1) / NW, ns_ = (MS + NW - 1) / NW, ntot = np_ + ns_;
        f32x4 lg[4], lb[4];
#pragma unroll
        for (int i = 0; i < 4; ++i) { lg[i] = *(const f32x4*)(p.in[27] + i * 256 + lane * 4); lb[i] = *(const f32x4*)(p.in[28] + i * 256 + lane * 4); }
        for (int k0 = 0; k0 < ntot; k0 += 8) {
            f32x4 v[8][4];
#pragma unroll
            for (int q = 0; q < 8; ++q) { const int rr = (k0 + q < ntot) ? ln_row_of(k0 + q, wg_, np_, ns_) : -1; const int r = rr < 0 ? 0 : rr;
#pragma unroll
                for (int i = 0; i < 4; ++i) { if (r < MP) { const u32x2 t = ldnt2(H + (size_t)r * 1024 + i * 256 + lane * 4); v[q][i] = (f32x4){bf_lo(t[0]), bf_hi(t[0]), bf_lo(t[1]), bf_hi(t[1])}; }
                    else { const float* tp = TS2 + (size_t)(r - MP) * 1024 + i * 256 + lane * 4; f32x4 a = *(const f32x4*)tp;
                        if (G == 256) { for (int sl = 1; sl < 8; ++sl) a += *(const f32x4*)(tp + (size_t)sl * 2048 * 1024); } v[q][i] = a; } } }
#pragma unroll
            for (int q = 0; q < 8; ++q) { const int r = (k0 + q < ntot) ? ln_row_of(k0 + q, wg_, np_, ns_) : -1; if (r >= 0) {
                ln_row(v[q]);
#pragma unroll
                for (int i = 0; i < 4; ++i) { const int col = i * 256 + lane * 4; stnt4(out + (size_t)r * 1024 + col, v[q][i] * lg[i] + lb[i]); } } }
        }
    }
}

extern "C" void kernel_launch(void* const* d_in, const int* in_sizes, int n_in, void* d_out, int out_size, void* d_ws, size_t ws_size, hipStream_t stream) {
    static int grid_blocks = 0;
    if (!grid_blocks) {
        int dev = 0, cus = 0, per_cu = 0;
        hipGetDevice(&dev);
        hipDeviceGetAttribute(&cus, hipDeviceAttributeMultiprocessorCount, dev);
        hipFuncSetAttribute((const void*)mega, hipFuncAttributeMaxDynamicSharedMemorySize, LDS_BYTES);
        hipOccupancyMaxActiveBlocksPerMultiprocessor(&per_cu, (const void*)mega, 512, LDS_BYTES);
        if (per_cu < 1) { fprintf(stderr, "kernel_launch: occupancy query says %d blocks/CU\n", per_cu); per_cu = 1; }
        if (per_cu > 1) per_cu = 1;
        grid_blocks = cus * per_cu;
        if (ws_size < W_END) fprintf(stderr, "kernel_launch: workspace too small: %zu < %zu\n", ws_size, (size_t)W_END);
    }
    hipMemsetAsync((unsigned char*)d_ws + W_BAR, 0, 16384, stream);
    Params p{};
    for (int i = 0; i < 29; ++i) p.in[i] = (const float*)d_in[i];
    p.out = (float*)d_out; p.ws = (unsigned char*)d_ws;
#if MK_LAUNCHES == 1
    p.ph_lo = 0; p.ph_hi = NPHASE;
    void* args[] = {&p};
    hipError_t e = hipLaunchCooperativeKernel((const void*)mega, dim3(grid_blocks), dim3(512), args, LDS_BYTES, stream);
    if (e != hipSuccess) fprintf(stderr, "cooperative launch failed: %s (grid %d)\n", hipGetErrorString(e), grid_blocks);
#else
    for (int ph = 0; ph < NPHASE; ++ph) { p.ph_lo = ph; p.ph_hi = ph + 1;
        for (int rep = 0; rep <= ((HOSTREP >> ph) & 1); ++rep) hipLaunchKernelGGL(mega, dim3(grid_blocks), dim3(512), LDS_BYTES, stream, p); }
#endif
}
```
